# Optimizing an MI355X kernel written in HIP

```python
import functools
import jax, jax.numpy as jnp
from jax import lax
import numpy as np


D_MODEL = 1024
BATCH = 2
SEQ = 16384
DEPTH = 2

N_MIXERS = 2
N_SUB = 3
EPS = 1e-6

HG_KDIM = 128
HG_HEADS = D_MODEL // HG_KDIM
HG_VDIM = D_MODEL // HG_HEADS
HG_F = HG_HEADS * HG_KDIM
HG_CHUNK = 64

GM_FFN = 6 * D_MODEL
GM_HALF = GM_FFN // 2
GM_GROUPS = 8
GM_GDIM = GM_HALF // GM_GROUPS
GM_CHUNK = 128

D_FF = ((8 * D_MODEL // 3 + 127) // 128) * 128

N_HGRN = (DEPTH + 1) // 2
N_GMLP = DEPTH // 2

kernel_name = "hybrid_hgrn2_gmlp_macaron_adaln"


def rms_norm(h, g):
    hf = h.astype(jnp.float32)
    y = hf * lax.rsqrt(jnp.mean(hf * hf, axis=-1, keepdims=True) + EPS)
    return (y * g.astype(jnp.float32)).astype(h.dtype)


def layer_norm(h, g, b):
    hf = h.astype(jnp.float32)
    mu = jnp.mean(hf, axis=-1, keepdims=True)
    d = hf - mu
    y = d * lax.rsqrt(jnp.mean(d * d, axis=-1, keepdims=True) + EPS)
    return (y * g.astype(jnp.float32) + b.astype(jnp.float32)).astype(h.dtype)


def swiglu(h, w_in, w_out):
    a, b = jnp.split(h @ w_in, 2, axis=-1)
    return (jax.nn.silu(a) * b) @ w_out


def hgrn2_mix(h, w_in, w_out, out_norm, lb):
    B, S, _ = h.shape
    f32 = jnp.float32
    proj = h @ w_in
    q, f, i, g = jnp.split(proj, [HG_F, 2 * HG_F, 2 * HG_F + D_MODEL], axis=-1)
    q = jax.nn.silu(q.astype(f32))
    fx = f.astype(f32)
    log_f = jnp.logaddexp(jnp.log(lb), jnp.log1p(-lb) + jax.nn.log_sigmoid(fx))
    k = (1.0 - lb) * jax.nn.sigmoid(-fx)
    nc = S // HG_CHUNK

    def to_chunks(t, d):
        return t.reshape(B, nc, HG_CHUNK, HG_HEADS, d).transpose(1, 0, 3, 2, 4)

    qc = to_chunks(q, HG_KDIM)
    kc = to_chunks(k, HG_KDIM)
    vc = to_chunks(i.astype(f32), HG_VDIM)
    bc = jnp.cumsum(to_chunks(log_f, HG_KDIM), axis=3)
    causal = jnp.tril(jnp.ones((HG_CHUNK, HG_CHUNK), bool))[:, :, None]

    def step(state, inp):
        qb, kb, vb, bb = inp
        o_inter = jnp.einsum('bhtk,bhkv->bhtv', qb * jnp.exp(bb), state)
        diff = bb[:, :, :, None, :] - bb[:, :, None, :, :]
        decay = jnp.exp(jnp.where(causal, diff, -jnp.inf))
        scores = jnp.einsum('bhtk,bhtsk,bhsk->bhts', qb, decay, kb)
        o_intra = jnp.einsum('bhts,bhsv->bhtv', scores, vb)
        b_last = bb[:, :, -1:, :]
        k_dec = kb * jnp.exp(b_last - bb)
        new_state = state * jnp.exp(b_last[:, :, 0, :, None]) + jnp.einsum('bhsk,bhsv->bhkv', k_dec, vb)
        return new_state, o_inter + o_intra

    state0 = jnp.zeros((B, HG_HEADS, HG_KDIM, HG_VDIM), f32)
    _, o = lax.scan(step, state0, (qc, kc, vc, bc))
    o = o.transpose(1, 0, 3, 2, 4).reshape(B, S, HG_HEADS, HG_VDIM)
    gate = jax.nn.silu(g.astype(f32)).reshape(B, S, HG_HEADS, HG_VDIM)
    o = rms_norm(o, out_norm) * gate
    return o.reshape(B, S, D_MODEL).astype(h.dtype) @ w_out


def gmlp_mix(h, w_in, b_in, ln_g, ln_b, w_s, b_s, w_out):
    B, S, _ = h.shape
    z = jax.nn.gelu(h @ w_in + b_in)
    u, v = jnp.split(z, 2, axis=-1)
    v = layer_norm(v, ln_g, ln_b)
    nc = S // GM_CHUNK
    vc = v.reshape(B, nc, GM_CHUNK, GM_GROUPS, GM_GDIM)
    ws = w_s * jnp.tril(jnp.ones((GM_CHUNK, GM_CHUNK), w_s.dtype))[None]
    vm = jnp.einsum('gts,bnsgc->bntgc', ws, vc) + b_s.T[None, None, :, :, None]
    return (u * vm.reshape(B, S, GM_HALF)) @ w_out


def sublayer(x, fn, pre_g, post_g, shift, scale, gate, res_w):
    h = rms_norm(x, pre_g) * (1.0 + scale) + shift
    return x + res_w * gate * rms_norm(fn(h), post_g)


def setup_inputs(seed: int = 0) -> dict:
    key = jax.random.key(seed)
    ks = jax.random.split(key, 24)
    f32 = jnp.float32

    def nrm(k, shape, s):
        return s * jax.random.normal(k, shape, f32)

    return {
        "x": nrm(ks[0], (BATCH, SEQ, D_MODEL), 1.0),
        "c": nrm(ks[1], (BATCH, D_MODEL), 1.0),
        "ada_w": nrm(ks[2], (DEPTH, D_MODEL, 3 * N_SUB * D_MODEL), 0.5 * D_MODEL ** -0.5),
        "ada_b": nrm(ks[3], (DEPTH, 3 * N_SUB * D_MODEL), 0.02),
        "norm_pre": 1.0 + nrm(ks[4], (DEPTH, N_SUB, D_MODEL), 0.02),
        "norm_post": 1.0 + nrm(ks[5], (DEPTH, N_SUB, D_MODEL), 0.02),
        "ffn_w_in": nrm(ks[6], (DEPTH, 2, D_MODEL, 2 * D_FF), D_MODEL ** -0.5),
        "ffn_w_out": nrm(ks[7], (DEPTH, 2, D_FF, D_MODEL), D_FF ** -0.5),
        "hg_w_in": nrm(ks[8], (N_HGRN, D_MODEL, 2 * HG_F + 2 * D_MODEL), D_MODEL ** -0.5),
        "hg_w_out": nrm(ks[9], (N_HGRN, D_MODEL, D_MODEL), D_MODEL ** -0.5),
        "hg_out_norm": 1.0 + nrm(ks[10], (N_HGRN, HG_VDIM), 0.02),
        "hg_lb": nrm(ks[11], (DEPTH + 1, HG_F), 0.1),
        "gm_w_in": nrm(ks[12], (N_GMLP, D_MODEL, GM_FFN), D_MODEL ** -0.5),
        "gm_b_in": nrm(ks[13], (N_GMLP, GM_FFN), 0.02),
        "gm_ln_g": 1.0 + nrm(ks[14], (N_GMLP, GM_HALF), 0.02),
        "gm_ln_b": nrm(ks[15], (N_GMLP, GM_HALF), 0.02),
        "gm_w_s": nrm(ks[16], (N_GMLP, GM_GROUPS, GM_CHUNK, GM_CHUNK), GM_CHUNK ** -0.5),
        "gm_b_s": 1.0 + nrm(ks[17], (N_GMLP, GM_GROUPS, GM_CHUNK), 0.02),
        "gm_w_out": nrm(ks[18], (N_GMLP, GM_HALF, D_MODEL), GM_HALF ** -0.5),
    }


def reference(x, c, ada_w, ada_b, norm_pre, norm_post, ffn_w_in, ffn_w_out,
              hg_w_in, hg_w_out, hg_out_norm, hg_lb,
              gm_w_in, gm_b_in, gm_ln_g, gm_ln_b, gm_w_s, gm_b_s, gm_w_out):
    B = x.shape[0]
    lb_all = jnp.cumsum(jax.nn.softmax(hg_lb.astype(jnp.float32), axis=0), axis=0)
    cond = jax.nn.silu(c)
    for i in range(DEPTH):
        mod = (cond @ ada_w[i] + ada_b[i]).reshape(B, 3 * N_SUB, D_MODEL)[:, :, None, :]
        j = i // N_MIXERS
        if i % N_MIXERS == 0:
            mixer = functools.partial(hgrn2_mix, w_in=hg_w_in[j], w_out=hg_w_out[j],
                                      out_norm=hg_out_norm[j], lb=lb_all[i])
        else:
            mixer = functools.partial(gmlp_mix, w_in=gm_w_in[j], b_in=gm_b_in[j], ln_g=gm_ln_g[j],
                                      ln_b=gm_ln_b[j], w_s=gm_w_s[j], b_s=gm_b_s[j], w_out=gm_w_out[j])
        fns = (functools.partial(swiglu, w_in=ffn_w_in[i, 0], w_out=ffn_w_out[i, 0]),
               mixer,
               functools.partial(swiglu, w_in=ffn_w_in[i, 1], w_out=ffn_w_out[i, 1]))
        res_ws = (0.5, 1.0, 0.5)
        for s in range(N_SUB):
            x = sublayer(x, fns[s], norm_pre[i, s], norm_post[i, s],
                         mod[:, 3 * s], mod[:, 3 * s + 1], mod[:, 3 * s + 2], res_ws[s])
    return x
```

```cpp
#include <hip/hip_runtime.h>
#include <hip/hip_cooperative_groups.h>
#include <cstdio>
#include <cstdint>
namespace cg = cooperative_groups;
__device__ __forceinline__ int TID() { int t = threadIdx.x; asm volatile("" : "+v"(t)); return t; }
__device__ __forceinline__ int BID() { int b = blockIdx.x; asm volatile("" : "+s"(b)); return b; }
#ifndef GEMM_WGM
#define GEMM_WGM 8
#endif
namespace pg8 {
#define PG8_LAS __attribute__((address_space(3)))
typedef unsigned short bf16_t;
typedef short bf16x8 __attribute__((ext_vector_type(8)));
typedef float f32x4 __attribute__((ext_vector_type(4)));
typedef unsigned u32x4 __attribute__((ext_vector_type(4)));
constexpr int BM = 256, BK = 64, HALF = 128, HTB = HALF * BK * 2  , STAGE_BYTES = 8 * HTB, NXCD = 8, WGM = GEMM_WGM;

__host__ __device__ __forceinline__ int lds_byte(int r, int c) { const int st = (r >> 4) * 2 + (c >> 5), rr = r & 15, cc = c & 31, ob = rr * 64 + cc * 2; return st * 1024 + (ob ^ (((ob >> 9) & 1) << 5)); }
__host__ __device__ __forceinline__ void stage_rc(int b, int& R, int& C) { const int st = b / 1024, sb = b % 1024, swz = sb ^ (((sb >> 9) & 1) << 5); R = (st >> 1) * 16 + swz / 64; C = (st & 1) * 32 + (swz % 64) / 2; }
__host__ __device__ __forceinline__ int perm32(int rho) { const int n = rho >> 4, i = rho & 15; return 8 * (i >> 2) + 4 * n + (i & 3); }

struct Unit { int pm, pn; };
struct Gemm { const bf16_t* A; const bf16_t* Bt; int M, N, K; };

struct StaticOrder {
    int nM, nN, nwg, G, c;
    __host__ __device__ void init(int M, int N, int G_, int c_) { nM = M / BM; nN = N / BM; nwg = nM * nN; G = G_; c = c_; }
    __host__ __device__ bool next(int i, Unit& u) const {
        const long L = (long)i * G + c; if (L >= nwg) return false;
        int wgid = (int)L; { const int q = nwg / NXCD, r = nwg % NXCD, xcd = wgid % NXCD, off = wgid / NXCD; wgid = (xcd < r ? xcd * (q + 1) : r * (q + 1) + (xcd - r) * q) + off; }
        const int nig = WGM * nN, gid = wgid / nig, fm = gid * WGM, gsz = (nM - fm) < WGM ? (nM - fm) : WGM;
        u.pm = fm + ((wgid % nig) % gsz); u.pn = (wgid % nig) / gsz; return true;
    }
    __device__ __forceinline__ void a_ready(const Unit&) const {}
    __device__ __forceinline__ void done(const Unit&) const {}
};

__device__ __forceinline__ unsigned cvt_pk_bf16(float lo, float hi) { unsigned r; asm volatile("v_cvt_pk_bf16_f32 %0, %1, %2" : "=v"(r) : "v"(lo), "v"(hi)); return r; }
typedef float f32x2 __attribute__((ext_vector_type(2)));
template <class Epi, class Sched, bool ALIGN_EPI = false, bool SP2 = false>
__device__ __forceinline__ void gemm_phase(PG8_LAS unsigned char* lds, const Gemm g, const Sched& S, const Epi& E) {
    const int tid = TID(), wid = __builtin_amdgcn_readfirstlane(tid >> 6), lane = tid & 63, wr = wid >> 2, wc = wid & 3, fr = lane & 15, fq = lane >> 4;
    const int K = g.K, nt = K / BK;
    unsigned voffA[2], voffB[2];
#pragma unroll
    for (int i = 0; i < 2; ++i) { int R, C; stage_rc(tid * 16 + i * 8192, R, C); const int Rb = Epi::PERM ? ((R & ~31) + perm32(R & 31)) : R;
        voffA[i] = (unsigned)(R * K + C) * 2u; voffB[i] = (unsigned)(Rb * K + C) * 2u; }
    const size_t kstep = (size_t)(BK * 2);
    const size_t hstep = (size_t)HALF * K * 2;
    const size_t tstep = 2 * hstep;
    const unsigned ldsw = (unsigned)wid * 1024u;
    const int aoff = lds_byte(wr * 64 + fr, fq * 8), boff = lds_byte(wc * 32 + fr, fq * 8);
#define PG8_SA(b, h) (((b) * 2 + (h)) * HTB)
#define PG8_SB(b, h) ((4 + (b) * 2 + (h)) * HTB)
#define PG8_STAGE(bufoff, gbase, voff) do { _Pragma("unroll") for (int _i = 0; _i < 2; ++_i) \
        __builtin_amdgcn_global_load_lds((const unsigned*)((const char*)(gbase) + (voff)[_i]), (PG8_LAS unsigned*)(lds + (bufoff) + ldsw + _i * 8192), 16, 0, 0); } while (0)
#define PG8_LDA(dst, b, h) do { _Pragma("unroll") for (int m = 0; m < 4; ++m) _Pragma("unroll") for (int k = 0; k < 2; ++k) dst[m][k] = *(const PG8_LAS bf16x8*)(lds + PG8_SA(b, h) + aoff + m * 2048 + k * 1024); } while (0)
#define PG8_LDB(dst, b, h) do { _Pragma("unroll") for (int n = 0; n < 2; ++n) _Pragma("unroll") for (int k = 0; k < 2; ++k) dst[n][k] = *(const PG8_LAS bf16x8*)(lds + PG8_SB(b, h) + boff + n * 2048 + k * 1024); } while (0)
#define PG8_MMA(ai, bj, At, Bt) do { __builtin_amdgcn_s_setprio(1); _Pragma("unroll") for (int m = 0; m < 4; ++m) _Pragma("unroll") for (int n = 0; n < 2; ++n) _Pragma("unroll") for (int k = 0; k < 2; ++k) \
        acc[ai][bj][m][n] = __builtin_amdgcn_mfma_f32_16x16x32_bf16(Bt[n][k], At[m][k], acc[ai][bj][m][n], 0, 0, 0); __builtin_amdgcn_s_setprio(0); } while (0)
#define PG8_WAIT_V(n) asm volatile("s_waitcnt vmcnt(" #n ")" ::: "memory")
#define PG8_WAIT_L(n) asm volatile("s_waitcnt lgkmcnt(" #n ")" ::: "memory")
#define PG8_BAR __builtin_amdgcn_s_barrier()
#define PG8_SCHED __builtin_amdgcn_sched_barrier(0)
    Unit cur, nxt; int ui = 0;
    if (!S.next(0, cur)) return;
    f32x4 acc[2][2][4][2];
#pragma unroll
    for (int a = 0; a < 2; ++a)
#pragma unroll
        for (int b = 0; b < 2; ++b)
#pragma unroll
            for (int m = 0; m < 4; ++m)
#pragma unroll
                for (int n = 0; n < 2; ++n) acc[a][b][m][n] = (f32x4){0.f, 0.f, 0.f, 0.f};
    bf16x8 At[4][2], B0[2][2], B1[2][2];
    const char* cA = (const char*)g.A + (size_t)cur.pm * tstep; const char* cB = (const char*)g.Bt + (size_t)cur.pn * tstep;
    S.a_ready(cur);
    if constexpr (SP2) {
        PG8_STAGE(PG8_SB(0, 0), cB, voffB); PG8_STAGE(PG8_SB(0, 1), cB + hstep, voffB); PG8_STAGE(PG8_SA(0, 0), cA, voffA); PG8_STAGE(PG8_SA(0, 1), cA + hstep, voffA);
        if (wr == 1) PG8_BAR;
        PG8_WAIT_V(2); PG8_BAR;
        PG8_STAGE(PG8_SB(1, 0), cB + kstep, voffB); PG8_STAGE(PG8_SA(1, 0), cA + kstep, voffA); PG8_STAGE(PG8_SB(1, 1), cB + hstep + kstep, voffB);
        PG8_WAIT_V(6); PG8_BAR;
    } else {
        PG8_STAGE(PG8_SB(0, 0), cB, voffB); PG8_STAGE(PG8_SA(0, 0), cA, voffA); PG8_STAGE(PG8_SB(0, 1), cB + hstep, voffB); PG8_STAGE(PG8_SA(0, 1), cA + hstep, voffA);
        if (wr == 1) PG8_BAR;
        PG8_WAIT_V(4); PG8_BAR;
        PG8_STAGE(PG8_SB(1, 0), cB + kstep, voffB); PG8_STAGE(PG8_SA(1, 0), cA + kstep, voffA); PG8_STAGE(PG8_SB(1, 1), cB + hstep + kstep, voffB);
        PG8_WAIT_V(6); PG8_BAR;
    }
    for (;;) {
        const bool has_next = S.next(ui + 1, nxt);
        const char* nA = has_next ? (const char*)g.A + (size_t)nxt.pm * tstep : cA; const char* nB = has_next ? (const char*)g.Bt + (size_t)nxt.pn * tstep : cB;
        for (int t = 0; t < nt; t += 2) {
            const bool last = (t == nt - 2);
            const char* a1 = cA + (size_t)(t + 1) * kstep;
            const char* a2 = last ? nA : cA + (size_t)(t + 2) * kstep; const char* b2 = last ? nB : cB + (size_t)(t + 2) * kstep;
            const char* a3 = a2 + kstep; const char* b3 = b2 + kstep;
            if (last && has_next) S.a_ready(nxt);
            if constexpr (SP2) {
            PG8_LDB(B0, 0, 0); PG8_LDB(B1, 0, 1); PG8_SCHED; PG8_LDA(At, 0, 0); PG8_STAGE(PG8_SA(1, 1), a1 + hstep, voffA);
            PG8_WAIT_V(8); PG8_WAIT_L(0); PG8_BAR; PG8_MMA(0, 0, At, B0); PG8_MMA(0, 1, At, B1); PG8_BAR; PG8_SCHED;
            PG8_LDA(At, 0, 1); PG8_STAGE(PG8_SB(0, 0), b2, voffB); PG8_STAGE(PG8_SB(0, 1), b2 + hstep, voffB); PG8_STAGE(PG8_SA(0, 0), a2, voffA);
            PG8_WAIT_V(8); PG8_WAIT_L(0); PG8_BAR; PG8_MMA(1, 0, At, B0); PG8_MMA(1, 1, At, B1); PG8_BAR; PG8_SCHED;
            PG8_LDB(B0, 1, 0); PG8_LDB(B1, 1, 1); PG8_SCHED; PG8_LDA(At, 1, 0); PG8_STAGE(PG8_SA(0, 1), a2 + hstep, voffA);
            PG8_WAIT_V(8); PG8_WAIT_L(0); PG8_BAR; PG8_MMA(0, 0, At, B0); PG8_MMA(0, 1, At, B1); PG8_BAR; PG8_SCHED;
            PG8_LDA(At, 1, 1); PG8_STAGE(PG8_SB(1, 0), b3, voffB); PG8_STAGE(PG8_SB(1, 1), b3 + hstep, voffB); PG8_STAGE(PG8_SA(1, 0), a3, voffA);
            PG8_WAIT_V(8); PG8_WAIT_L(0); PG8_BAR; PG8_MMA(1, 0, At, B0); PG8_MMA(1, 1, At, B1); PG8_BAR; PG8_SCHED;
            } else {
            PG8_LDB(B0, 0, 0); PG8_SCHED; PG8_LDA(At, 0, 0); PG8_STAGE(PG8_SA(1, 1), a1 + hstep, voffA);
            PG8_WAIT_L(8); PG8_BAR; PG8_WAIT_L(0); PG8_MMA(0, 0, At, B0); PG8_BAR; PG8_SCHED;
            PG8_LDB(B1, 0, 1); PG8_STAGE(PG8_SB(0, 0), b2, voffB);
            PG8_BAR; PG8_WAIT_L(0); PG8_MMA(0, 1, At, B1); PG8_BAR;
            PG8_LDA(At, 0, 1); PG8_STAGE(PG8_SA(0, 0), a2, voffA);
            PG8_BAR; PG8_WAIT_L(0); PG8_MMA(1, 0, At, B0); PG8_BAR; PG8_SCHED;
            PG8_STAGE(PG8_SB(0, 1), b2 + hstep, voffB);
            PG8_WAIT_V(6); PG8_BAR; PG8_MMA(1, 1, At, B1); PG8_BAR;
            PG8_LDB(B0, 1, 0); PG8_SCHED; PG8_LDA(At, 1, 0); PG8_STAGE(PG8_SA(0, 1), a2 + hstep, voffA);
            PG8_WAIT_L(8); PG8_BAR; PG8_WAIT_L(0); PG8_MMA(0, 0, At, B0); PG8_BAR; PG8_SCHED;
            PG8_LDB(B1, 1, 1); PG8_STAGE(PG8_SB(1, 0), b3, voffB);
            PG8_BAR; PG8_WAIT_L(0); PG8_MMA(0, 1, At, B1); PG8_BAR;
            PG8_LDA(At, 1, 1); PG8_STAGE(PG8_SA(1, 0), a3, voffA);
            PG8_BAR; PG8_WAIT_L(0); PG8_MMA(1, 0, At, B0); PG8_BAR; PG8_SCHED;
            PG8_STAGE(PG8_SB(1, 1), b3 + hstep, voffB);
            PG8_WAIT_V(6); PG8_BAR; PG8_MMA(1, 1, At, B1); PG8_BAR;
            }
        }
        if constexpr (ALIGN_EPI) { if (wr == 0) PG8_BAR; }
        if constexpr (!Epi::AFTER_DRAIN) { E(acc, cur, wr, wc, fr, fq); S.done(cur); }
        if (!has_next) break;
#pragma unroll
        for (int a = 0; a < 2; ++a)
#pragma unroll
            for (int b = 0; b < 2; ++b)
#pragma unroll
                for (int m = 0; m < 4; ++m)
#pragma unroll
                    for (int n = 0; n < 2; ++n) acc[a][b][m][n] = (f32x4){0.f, 0.f, 0.f, 0.f};
        cur = nxt; cA = nA; cB = nB; ++ui;
        if constexpr (ALIGN_EPI) { if (wr == 1) PG8_BAR; }
    }
    PG8_WAIT_V(0);
    if constexpr (!ALIGN_EPI) { if (wr == 0) PG8_BAR; }
    PG8_BAR;
    if constexpr (Epi::AFTER_DRAIN) { E.fused(acc, cur, wr, wc, fr, fq, lds, wid, lane); S.done(cur); }
#undef PG8_SA
#undef PG8_SB
#undef PG8_STAGE
#undef PG8_LDA
#undef PG8_LDB
#undef PG8_MMA
#undef PG8_WAIT_V
#undef PG8_WAIT_L
#undef PG8_BAR
#undef PG8_SCHED
}
}
#define LAS __attribute__((address_space(3)))
#define XB_TMO      128
#define XB_XCNT(j)  (256  + 64 * (j))
#define XB_XSUB(j)  (1280 + 64 * (j))
#define XB_XGEN(j)  (2304 + 64 * (j))
#define XB_TOP      3328
#define XB_TOPGEN   3392
#define XCD_BAR_WORDS 3456
#define XB_SPIN_CAP (1u << 18)

__device__ __forceinline__ unsigned xb_ld(unsigned* p)              { return __hip_atomic_load(p, __ATOMIC_RELAXED, __HIP_MEMORY_SCOPE_AGENT); }
__device__ __forceinline__ unsigned xb_add(unsigned* p, unsigned v) { return __hip_atomic_fetch_add(p, v, __ATOMIC_RELAXED, __HIP_MEMORY_SCOPE_AGENT); }
__device__ __forceinline__ unsigned xb_xcc_id() { return (unsigned)__builtin_amdgcn_s_getreg((3 << 11) | 20) & 0xFu; }
#define XB_SPIN(cond, bar) do { unsigned _sp = 0; while (cond) { __builtin_amdgcn_s_sleep(1); \
    if ((++_sp & 255u) == 0u) { if (xb_ld(&(bar)[XB_TMO])) break; if (_sp > XB_SPIN_CAP) { atomicAdd(&(bar)[XB_TMO], 1u); break; } } } } while (0)

struct XcdBarrier {
    unsigned* bar; unsigned x;
    volatile LAS unsigned* st;
};

__device__ __forceinline__ XcdBarrier xcd_barrier_post(unsigned* bar, volatile LAS unsigned* st) {
    XcdBarrier b; b.bar = bar; b.x = xb_xcc_id(); b.st = st;
    if (threadIdx.x == 0) (void)xb_add(&bar[XB_XCNT(b.x)], 1u);
    return b;
}
__device__ __forceinline__ void xcd_barrier_complete(unsigned* bar, unsigned x, unsigned& nloc, unsigned& nx) {
    const unsigned G = gridDim.x * gridDim.y * gridDim.z;
    unsigned sum, cnt, mine, sp = 0u;
    for (;;) {
        sum = 0u; cnt = 0u; mine = 0u;
#pragma unroll
        for (unsigned j = 0; j < 16; ++j) { const unsigned c = xb_ld(&bar[XB_XCNT(j)]); sum += c; cnt += (c > 0u) ? 1u : 0u; mine = (j == x) ? c : mine; }
        if (sum == G) break;
        __builtin_amdgcn_s_sleep(1);
        if ((++sp & 255u) == 0u) { if (xb_ld(&bar[XB_TMO])) break; if (sp > XB_SPIN_CAP) { atomicAdd(&bar[XB_TMO], 1u); break; } }
    }
    nloc = mine > 0u ? mine : 1u; nx = cnt > 0u ? cnt : 1u;
}

__device__ __forceinline__ void xcd_barrier(const XcdBarrier& b) {
    asm volatile("s_waitcnt vmcnt(0)" ::: "memory");
    __syncthreads();
    if (threadIdx.x == 0) {
        unsigned* bar = b.bar;
        __builtin_amdgcn_s_waitcnt(0);
        unsigned nloc = b.st[0], nx = b.st[1];
        if (nloc == 0u) { xcd_barrier_complete(bar, b.x, nloc, nx); b.st[0] = nloc; b.st[1] = nx; }
        const unsigned old = xb_add(&bar[XB_XSUB(b.x)], 1u);
        const unsigned gen = old / nloc;
        if (old + 1u == (gen + 1u) * nloc) {
            __builtin_amdgcn_fence(__ATOMIC_RELEASE, "agent");
            asm volatile("s_waitcnt vmcnt(0)" ::: "memory");
            const unsigned og = xb_add(&bar[XB_TOP], 1u);
            const unsigned tg = og / nx;
            if (og + 1u == (tg + 1u) * nx) xb_add(&bar[XB_TOPGEN], 1u);
            else XB_SPIN(xb_ld(&bar[XB_TOPGEN]) == tg, bar);
            __builtin_amdgcn_fence(__ATOMIC_ACQUIRE, "agent");
            xb_add(&bar[XB_XGEN(b.x)], 1u);
            asm volatile("s_waitcnt vmcnt(0)" ::: "memory");
        } else {
            XB_SPIN(xb_ld(&bar[XB_XGEN(b.x)]) == gen, bar);
            __builtin_amdgcn_fence(__ATOMIC_ACQUIRE, "agent");
            asm volatile("s_waitcnt vmcnt(0)" ::: "memory");
        }
    }
    __syncthreads();
}
#ifndef PROBE
#define PROBE 0
#endif

using pg8::bf16_t; using pg8::bf16x8; using pg8::f32x4; using pg8::u32x4; using pg8::cvt_pk_bf16;

typedef unsigned u32x2 __attribute__((ext_vector_type(2)));
typedef float f32x2v __attribute__((ext_vector_type(2)));

constexpr int T = 32768, D = 1024, DFF = 2816, SEQ = 16384;
constexpr int LDS_BYTES = 151552;
constexpr float EPS = 1e-6f;
constexpr size_t MiB = 1ull << 20;
constexpr size_t OFF_W = 0;
constexpr size_t OFF_R1 = 52 * MiB;
constexpr size_t OFF_YH = OFF_R1 + 192 * MiB;
constexpr size_t OFF_MOD = OFF_YH + 64 * MiB;
constexpr size_t OFF_PART = OFF_MOD + 256 * 1024;
constexpr size_t OFF_BAR = OFF_PART + 6 * MiB;
constexpr size_t OFF_R2 = OFF_BAR + 16384;
constexpr int LDV = T + 64;
constexpr size_t WS_END = OFF_R2 + 193 * MiB;
constexpr size_t W_IN0 = 0, W_IN1 = (size_t)2 * DFF * D, W_OUT0 = (size_t)4 * DFF * D, W_OUT1 = W_OUT0 + (size_t)D * DFF, W_X = W_OUT1 + (size_t)D * DFF;
constexpr size_t W_HGOUT = W_X + (size_t)4096 * D, W_GMOUT = W_X + (size_t)6144 * D;

struct Params {
    const float* in[19];
    float* out; unsigned char* ws;
    int ph_lo, ph_hi;
};
#define CAS __attribute__((address_space(4)))
__device__ __forceinline__ const CAS Params* KP() { const CAS Params* q = (const CAS Params*)__builtin_amdgcn_kernarg_segment_ptr(); asm volatile("" : "+s"(q)); return q; }

__device__ __forceinline__ float frcp(float x) { return __builtin_amdgcn_rcpf(x); }
__device__ __forceinline__ float fexp(float x) { return __builtin_amdgcn_exp2f(x * 1.4426950408889634f); }
__device__ __forceinline__ float flog(float x) { return __builtin_amdgcn_logf(x) * 0.6931471805599453f; }
__device__ __forceinline__ float silu_f(float x) { return x * frcp(1.f + fexp(-x)); }
__device__ __forceinline__ float gelu_f(float x) { const float u = 1.5957691216f * (x + 0.044715f * x * x * x); return x * frcp(1.f + fexp(-u)); }
__device__ __forceinline__ f32x4 sigmoid4(const f32x4 x) {
    f32x4 r;
#pragma unroll
    for (int j = 0; j < 4; ++j) r[j] = __builtin_amdgcn_rcpf(1.f + __builtin_amdgcn_exp2f(x[j] * -1.4426950408889634f));
    return r;
}
__device__ __forceinline__ f32x4 silu4(const f32x4 x) { return x * sigmoid4(x); }
__device__ __forceinline__ f32x4 gelu4(const f32x4 x) { const f32x4 u = (x + x * x * x * 0.044715f) * 1.5957691216f; return x * sigmoid4(u); }
typedef _Float16 f16x2 __attribute__((ext_vector_type(2)));
__device__ __forceinline__ unsigned pk_h2(float a, float b) { f16x2 v; v.x = (_Float16)a; v.y = (_Float16)b; return __builtin_bit_cast(unsigned, v); }
__device__ __forceinline__ float h_lo(unsigned w) { return (float)__builtin_bit_cast(f16x2, w).x; }
__device__ __forceinline__ float h_hi(unsigned w) { return (float)__builtin_bit_cast(f16x2, w).y; }
__device__ __forceinline__ float bf_lo(unsigned w) { return __uint_as_float(w << 16); }
__device__ __forceinline__ float bf_hi(unsigned w) { return __uint_as_float(w & 0xffff0000u); }
__device__ __forceinline__ float bf1(unsigned short h) { return __uint_as_float(((unsigned)h) << 16); }
__device__ __forceinline__ u32x4 pack8(const f32x4 a, const f32x4 b) { u32x4 w; w.x = cvt_pk_bf16(a[0], a[1]); w.y = cvt_pk_bf16(a[2], a[3]); w.z = cvt_pk_bf16(b[0], b[1]); w.w = cvt_pk_bf16(b[2], b[3]); return w; }
#define DPP_ADD(v_, ctrl_, rm_) v_ += __builtin_bit_cast(float, __builtin_amdgcn_update_dpp(0, __builtin_bit_cast(int, v_), ctrl_, rm_, 0xF, false))
__device__ __forceinline__ float wave_sum(float v) {
    DPP_ADD(v, 0xB1, 0xF);
    DPP_ADD(v, 0x4E, 0xF);
    DPP_ADD(v, 0x141, 0xF);
    DPP_ADD(v, 0x140, 0xF);
    DPP_ADD(v, 0x142, 0xA);
    DPP_ADD(v, 0x143, 0xC);
    return __builtin_bit_cast(float, __builtin_amdgcn_readlane(__builtin_bit_cast(int, v), 63));
}
#define LDS_WAIT() asm volatile("s_waitcnt lgkmcnt(0)" ::: "memory")
#define LDS_BARRIER() do { asm volatile("s_waitcnt lgkmcnt(0)" ::: "memory"); __builtin_amdgcn_s_barrier(); asm volatile("" ::: "memory"); } while (0)

struct Epi {
    static constexpr bool PERM = true, AFTER_DRAIN = false;
    int mode_in;
    __device__ __forceinline__ void operator()(const f32x4 (&acc)[2][2][4][2], const pg8::Unit& u_in, int wr, int wc, int fr, int fq) const {
        if (mode_in == 7) return;
        const CAS Params* kp = KP();
        unsigned char* ws = kp->ws;
        pg8::Unit u = u_in; const int mode = mode_in & 7;
        if (mode_in & 8) { u.pm = 0; u.pn = u_in.pn & 3; }
        const int row0 = u.pm * 256 + wr * 64 + fr;
        if (mode == 0) {
            bf16_t* o0 = (bf16_t*)(ws + OFF_YH); constexpr int ldc = D;
            const int col0 = u.pn * 256 + wc * 32 + 8 * fq;
#pragma unroll
            for (int ai = 0; ai < 2; ++ai)
#pragma unroll
                for (int m = 0; m < 4; ++m) { bf16_t* rowp = o0 + (size_t)(row0 + ai * 128 + m * 16) * ldc + col0;
#pragma unroll
                    for (int bj = 0; bj < 2; ++bj) *(u32x4*)(rowp + bj * 128) = pack8(acc[ai][bj][m][0], acc[ai][bj][m][1]); }
        } else if (mode == 1) {
            bf16_t* o0 = (bf16_t*)(ws + OFF_R1); constexpr int ldc = DFF;
            const int col0 = u.pn * 128 + wc * 32 + 8 * fq;
#pragma unroll
            for (int ai = 0; ai < 2; ++ai)
#pragma unroll
                for (int m = 0; m < 4; ++m) { bf16_t* rowp = o0 + (size_t)(row0 + ai * 128 + m * 16) * ldc + col0;
                    const f32x4 r0 = silu4(acc[ai][0][m][0]) * acc[ai][1][m][0], r1 = silu4(acc[ai][0][m][1]) * acc[ai][1][m][1];
                    *(u32x4*)rowp = pack8(r0, r1); }
        } else if (mode == 2) {
            bf16_t* o0 = (bf16_t*)(ws + OFF_R1); bf16_t* o1 = (bf16_t*)(ws + OFF_R1 + 64 * MiB); bf16_t* o2 = (bf16_t*)(ws + OFF_R1 + 128 * MiB); bf16_t* o3 = (bf16_t*)(ws + OFF_R2 + 128 * MiB);
            bf16_t* f0 = (bf16_t*)(ws + OFF_R2); const float* p0 = kp->in[11];
            const int sect = u.pn >> 2;
            const int col0 = (u.pn & 3) * 256 + wc * 32 + 8 * fq;
            if (sect == 1) {
#pragma unroll
                for (int bj = 0; bj < 2; ++bj) {
                    const int c = col0 + bj * 128;
                    f32x4 lbv[2], omv[2];
#pragma unroll
                    for (int n = 0; n < 2; ++n) {
                        const f32x4 a0 = *(const f32x4*)(p0 + c + 4 * n), a1 = *(const f32x4*)(p0 + 1024 + c + 4 * n), a2 = *(const f32x4*)(p0 + 2048 + c + 4 * n);
#pragma unroll
                        for (int j = 0; j < 4; ++j) { const float mx = fmaxf(a0[j], fmaxf(a1[j], a2[j])); const float e0 = fexp(a0[j] - mx), e1 = fexp(a1[j] - mx), e2 = fexp(a2[j] - mx);
                            const float lb = e0 / (e0 + e1 + e2); lbv[n][j] = lb; omv[n][j] = 1.f - lb; }
                    }
#pragma unroll
                    for (int ai = 0; ai < 2; ++ai)
#pragma unroll
                        for (int m = 0; m < 4; ++m) { const size_t off = (size_t)(row0 + ai * 128 + m * 16) * 1024 + c;
                            f32x4 l0, l1;
                            const f32x4 g0 = sigmoid4(acc[ai][bj][m][0]), g1 = sigmoid4(acc[ai][bj][m][1]);
#pragma unroll
                            for (int j = 0; j < 4; ++j) { l0[j] = flog(lbv[0][j] + omv[0][j] * g0[j]); l1[j] = flog(lbv[1][j] + omv[1][j] * g1[j]); }
                            { u32x4 lw; lw.x = pk_h2(l0[0], l0[1]); lw.y = pk_h2(l0[2], l0[3]); lw.z = pk_h2(l1[0], l1[1]); lw.w = pk_h2(l1[2], l1[3]); *(u32x4*)(f0 + off) = lw; }
                            }
                }
            } else {
                bf16_t* dst = sect == 0 ? o0 : (sect == 2 ? o2 : o3);
                const bool act = sect != 2;
#pragma unroll
                for (int ai = 0; ai < 2; ++ai)
#pragma unroll
                    for (int m = 0; m < 4; ++m) { bf16_t* rowp = dst + (size_t)(row0 + ai * 128 + m * 16) * 1024 + col0;
#pragma unroll
                        for (int bj = 0; bj < 2; ++bj) { f32x4 v0 = acc[ai][bj][m][0], v1 = acc[ai][bj][m][1];
                            if (act) { v0 = silu4(v0); v1 = silu4(v1); }
                            *(u32x4*)(rowp + bj * 128) = pack8(v0, v1); } }
            }
        } else if (mode == 3) {
            bf16_t* o0 = (bf16_t*)(ws + OFF_R1); constexpr int ldc = 3072; const float* p0 = kp->in[13];
            const int col0 = u.pn * 256 + wc * 32 + 8 * fq;
            f32x4 bv[2][2];
#pragma unroll
            for (int bj = 0; bj < 2; ++bj)
#pragma unroll
                for (int n = 0; n < 2; ++n) bv[bj][n] = *(const f32x4*)(p0 + col0 + bj * 128 + 4 * n);
            u32x4 qc[2], qn[2];
            qc[0] = *(const u32x4*)(o0 + (size_t)row0 * ldc + col0); qc[1] = *(const u32x4*)(o0 + (size_t)row0 * ldc + col0 + 128); qn[0] = qc[0]; qn[1] = qc[1];
#pragma unroll
            for (int ai = 0; ai < 2; ++ai)
#pragma unroll
                for (int m = 0; m < 4; ++m) { bf16_t* rowp = o0 + (size_t)(row0 + ai * 128 + m * 16) * ldc + col0;
                    if (ai * 4 + m < 7) { const int nx = ai * 4 + m + 1; const bf16_t* np = o0 + (size_t)(row0 + (nx >> 2) * 128 + (nx & 3) * 16) * ldc + col0; qn[0] = *(const u32x4*)np; qn[1] = *(const u32x4*)(np + 128); }
                    asm volatile("" : "+v"(qc[0]), "+v"(qc[1]));
#pragma unroll
                    for (int bj = 0; bj < 2; ++bj) { f32x4 v0 = acc[ai][bj][m][0] + bv[bj][0], v1 = acc[ai][bj][m][1] + bv[bj][1];
                        const u32x4 q = qc[bj];
                        v0 = gelu4(v0) * (f32x4){bf_lo(q.x), bf_hi(q.x), bf_lo(q.y), bf_hi(q.y)}; v1 = gelu4(v1) * (f32x4){bf_lo(q.z), bf_hi(q.z), bf_lo(q.w), bf_hi(q.w)};
                        *(u32x4*)(rowp + bj * 128) = pack8(v0, v1); }
                    qc[0] = qn[0]; qc[1] = qn[1]; }
        } else {
            bf16_t* o0 = (bf16_t*)(ws + OFF_R2); constexpr int ldc = LDV; const float* p0 = kp->in[13] + 3072; float* part = (float*)(ws + OFF_PART);
            const int col0 = u.pn * 256 + wc * 32 + 8 * fq;
            f32x4 s[2][2], q[2][2];
#pragma unroll
            for (int bj = 0; bj < 2; ++bj)
#pragma unroll
                for (int n = 0; n < 2; ++n) { s[bj][n] = (f32x4){0.f, 0.f, 0.f, 0.f}; q[bj][n] = (f32x4){0.f, 0.f, 0.f, 0.f}; }
            float bv8[8];
#pragma unroll
            for (int i8 = 0; i8 < 8; ++i8) bv8[i8] = p0[row0 + (i8 >> 2) * 128 + (i8 & 3) * 16];
#pragma unroll
            for (int ai = 0; ai < 2; ++ai)
#pragma unroll
                for (int m = 0; m < 4; ++m) { const int row = row0 + ai * 128 + m * 16; const float bv = bv8[ai * 4 + m]; bf16_t* rowp = o0 + ((size_t)(u.pn * 2) * 3072 + row) * 128 + wc * 32 + 8 * fq;
#pragma unroll
                    for (int bj = 0; bj < 2; ++bj) { f32x4 v0 = acc[ai][bj][m][0] + bv, v1 = acc[ai][bj][m][1] + bv;
                        v0 = gelu4(v0); v1 = gelu4(v1);
                        s[bj][0] += v0; s[bj][1] += v1; q[bj][0] += v0 * v0; q[bj][1] += v1 * v1;
                        *(u32x4*)(rowp + (size_t)bj * 3072 * 128) = pack8(v0, v1); } }
#pragma unroll
            for (int bj = 0; bj < 2; ++bj)
#pragma unroll
                for (int n = 0; n < 2; ++n)
#pragma unroll
                    for (int j = 0; j < 4; ++j) {
                        { float sv = s[bj][n][j], qv = q[bj][n][j];
                          DPP_ADD(sv, 0xB1, 0xF); DPP_ADD(qv, 0xB1, 0xF); DPP_ADD(sv, 0x4E, 0xF); DPP_ADD(qv, 0x4E, 0xF); DPP_ADD(sv, 0x141, 0xF); DPP_ADD(qv, 0x141, 0xF); DPP_ADD(sv, 0x140, 0xF); DPP_ADD(qv, 0x140, 0xF);
                          s[bj][n][j] = sv; q[bj][n][j] = qv; } }
            if (fr == 0) {
                float* pp = part + ((size_t)(u.pm * 2 + wr) * T + col0) * 2;
#pragma unroll
                for (int bj = 0; bj < 2; ++bj)
#pragma unroll
                    for (int n = 0; n < 2; ++n) {
                        *(f32x4*)(pp + (bj * 128 + 4 * n) * 2) = (f32x4){s[bj][n][0], q[bj][n][0], s[bj][n][1], q[bj][n][1]};
                        *(f32x4*)(pp + (bj * 128 + 4 * n) * 2 + 4) = (f32x4){s[bj][n][2], q[bj][n][2], s[bj][n][3], q[bj][n][3]}; }
            }
        }
        if (PROBE == 16) asm volatile("s_waitcnt vmcnt(0)" ::: "memory");
    }
};

__device__ __forceinline__ void tp_params(const CAS Params* kp, int L, bf16_t* Wb, int it, int lane, const float*& sp, int& N, bf16_t*& dp, int& K) {
    const int nA = 2816, nB = 1408, nC = L == 0 ? 2048 : 3072;
    int r = it; const float* src; bf16_t* dst; int swz = 0;
    if (r < nA) { src = kp->in[6] + (size_t)(L * 2 + 0) * D * 2 * DFF; K = D; N = 2 * DFF; dst = Wb + W_IN0; swz = 1; }
    else if ((r -= nA) < nA) { src = kp->in[6] + (size_t)(L * 2 + 1) * D * 2 * DFF; K = D; N = 2 * DFF; dst = Wb + W_IN1; swz = 1; }
    else if ((r -= nA) < nB) { src = kp->in[7] + (size_t)(L * 2 + 0) * DFF * D; K = DFF; N = D; dst = Wb + W_OUT0; }
    else if ((r -= nB) < nB) { src = kp->in[7] + (size_t)(L * 2 + 1) * DFF * D; K = DFF; N = D; dst = Wb + W_OUT1; }
    else if ((r -= nB) < nC) { src = L == 0 ? kp->in[8] : kp->in[12]; K = D; N = L == 0 ? 4096 : 6144; dst = Wb + W_X; }
    else { r -= nC; src = L == 0 ? kp->in[9] : kp->in[18]; K = L == 0 ? D : 3072; N = D; dst = L == 0 ? Wb + W_HGOUT : Wb + W_GMOUT; }
    const int nblk = N >> 5, kb = r / nblk, nb = r - kb * nblk;
    const int dstrow0 = nb * 32, k0 = kb * 64;
    const int srccol0 = swz ? (((dstrow0 & 128) ? DFF : 0) + (dstrow0 >> 8) * 128 + (dstrow0 & 127)) : dstrow0;
    sp = src + (size_t)(k0 + (lane >> 5)) * N + srccol0 + (lane & 31);
    dp = dst + (size_t)(dstrow0 + (lane >> 3)) * K + k0 + 8 * (lane & 7);
}
__device__ __forceinline__ void tp_finish(const float (&R)[32], bf16_t* dp, int K, LAS float* scr, int lane) {
#pragma unroll
    for (int i = 0; i < 32; ++i) scr[(2 * i + (lane >> 5)) * 33 + (lane & 31)] = R[i];
    LDS_WAIT(); asm volatile("" ::: "memory");
    const int c = lane & 7;
    float tv[4][8];
#pragma unroll
    for (int j = 0; j < 4; ++j) { const LAS float* s = scr + (8 * c) * 33 + (lane >> 3) + 8 * j;
#pragma unroll
        for (int e8 = 0; e8 < 8; ++e8) tv[j][e8] = s[e8 * 33]; }
#pragma unroll
    for (int j = 0; j < 4; ++j) {
        u32x4 o; o.x = cvt_pk_bf16(tv[j][0], tv[j][1]); o.y = cvt_pk_bf16(tv[j][2], tv[j][3]); o.z = cvt_pk_bf16(tv[j][4], tv[j][5]); o.w = cvt_pk_bf16(tv[j][6], tv[j][7]);
        *(u32x4*)(dp + (size_t)(8 * j) * K) = o; }
    LDS_WAIT(); asm volatile("" ::: "memory");
}
__device__ __forceinline__ void prep_weights(LAS unsigned char* lds, int L) {
    const CAS Params* kp = KP();
    const int lane = TID() & 63, wave = TID() >> 6;
    LAS float* scr = (LAS float*)(lds + wave * 8448);
    bf16_t* Wb = (bf16_t*)(kp->ws + OFF_W);
    const int gw = BID() * 8 + wave, NGW = gridDim.x * 8;
    const int total = 2 * 2816 + 2 * 1408 + (L == 0 ? 2048 + 512 : 3072 + 1536);
    for (int it = gw; it < total; it += 2 * NGW) {
        const bool hasB = it + NGW < total;
        const float *spA, *spB; bf16_t *dpA, *dpB; int NA, NB, KA, KB;
        tp_params(kp, L, Wb, it, lane, spA, NA, dpA, KA);
        tp_params(kp, L, Wb, hasB ? it + NGW : it, lane, spB, NB, dpB, KB);
        float RA[32], RB[32];
#pragma unroll
        for (int i = 0; i < 32; ++i) RA[i] = spA[(size_t)(2 * i) * NA];
#pragma unroll
        for (int i = 0; i < 32; ++i) RB[i] = hasB ? spB[(size_t)(2 * i) * NB] : 0.f;
        tp_finish(RA, dpA, KA, scr, lane);
        if (hasB) tp_finish(RB, dpB, KB, scr, lane);
    }
}
__device__ __forceinline__ void mod_gemv(LAS unsigned char* lds) {
    const CAS Params* kp = KP(); const float* cin = kp->in[1]; const float* adaw = kp->in[2]; const float* adab = kp->in[3];
    const int tid = TID(), lane = tid & 63, wave = tid >> 6;
    LAS float* cond = (LAS float*)(lds + 73728);
    LAS float* red = (LAS float*)(lds + 73728 + 8192);
    float* mod = (float*)(kp->ws + OFF_MOD);
    __syncthreads();
    for (int i = tid; i < 2048; i += 512) cond[i] = silu_f(cin[i]);
    __syncthreads();
    for (int it = BID(); it < 144; it += gridDim.x) {
        const int l = it / 72, n = (it - l * 72) * 128 + 2 * lane;
        const float* w = adaw + (size_t)l * D * 9216 + n;
        const int k0 = wave * 128;
        f32x2v a0 = (f32x2v){0.f, 0.f}, a1 = a0;
#pragma unroll 32
        for (int k = 0; k < 128; ++k) { const f32x2v wv = *(const f32x2v*)(w + (size_t)(k0 + k) * 9216); a0 += wv * cond[k0 + k]; a1 += wv * cond[1024 + k0 + k]; }
        *(LAS f32x2v*)(red + (wave * 2 + 0) * 128 + 2 * lane) = a0; *(LAS f32x2v*)(red + (wave * 2 + 1) * 128 + 2 * lane) = a1;
        __syncthreads();
        if (tid < 256) { const int b = tid >> 7, ln = tid & 127; float sacc = 0.f;
#pragma unroll
            for (int w8 = 0; w8 < 8; ++w8) sacc += red[(w8 * 2 + b) * 128 + ln];
            const int n2 = (it - l * 72) * 128 + ln;
            mod[(size_t)(l * 2 + b) * 9216 + n2] = sacc + adab[l * 9216 + n2]; }
        __syncthreads();
    }
}

#ifndef XBF16
#define XBF16 1
#endif
__device__ __forceinline__ void norm_phase(int upd_l, int upd_s, int h_l, int h_s, int xsrc, int xdst, bool dummy, int vc) {
    const CAS Params* kp = KP(); unsigned char* ws = kp->ws; const float* npre = kp->in[4]; const float* npost = kp->in[5];
    const unsigned char* xin = xsrc == 0 ? (const unsigned char*)kp->in[0] : (xsrc == 1 || !XBF16) ? (const unsigned char*)kp->out : (const unsigned char*)(ws + OFF_R2);
    unsigned char* xout = dummy ? (ws + OFF_R2 + 64 * MiB) : ((xdst == 2 && XBF16) ? (ws + OFF_R2) : (unsigned char*)kp->out);
    const bool in_f32 = !XBF16 || xsrc == 0, out_f32 = !XBF16 || xdst == 3;
    const int lane = TID() & 63, wave = TID() >> 6;
#ifndef PROBE
#define PROBE 0
#endif
    const int bid_ = BID();
    if (PROBE == 15 && ((bid_ >> 3) & 1)) return;
    const int gw = (PROBE == 15 ? ((bid_ & 7) + 8 * (bid_ >> 4)) : bid_) * 8 + wave, NGW = (PROBE == 15 ? gridDim.x / 2 : gridDim.x) * 8;
    const float* mod = (const float*)(ws + OFF_MOD);
    const bf16_t* y = (const bf16_t*)(ws + OFF_YH);
    bf16_t* h = dummy ? (bf16_t*)(ws + OFF_R2 + 128 * MiB) : (bf16_t*)(ws + OFF_YH);
    const bool upd = upd_l >= 0, hh = h_l >= 0;
    const bool aff = gridDim.x == 256 && PROBE != 15;
    const int ax = vc & 7, aj = vc >> 3;
    for (int b = 0; b < 2; ++b) {
        if (aff && b != (ax >> 2)) continue;
        f32x4 A1[4], A2[4], A3[4];
#pragma unroll
        for (int j = 0; j < 4; ++j) { A1[j] = (f32x4){0.f, 0.f, 0.f, 0.f}; A2[j] = A1[j]; A3[j] = A1[j]; }
        if (upd) { const float rw = upd_s == 1 ? 1.0f : 0.5f;
            const f32x4* gate = (const f32x4*)(mod + ((size_t)(upd_l * 2 + b) * 9 + 3 * upd_s + 2) * D) + lane; const f32x4* post = (const f32x4*)(npost + (size_t)(upd_l * 3 + upd_s) * D) + lane;
#pragma unroll
            for (int j = 0; j < 4; ++j) A1[j] = gate[64 * j] * post[64 * j] * rw; }
        if (hh) { const f32x4* shift = (const f32x4*)(mod + ((size_t)(h_l * 2 + b) * 9 + 3 * h_s + 0) * D) + lane; const f32x4* scale = (const f32x4*)(mod + ((size_t)(h_l * 2 + b) * 9 + 3 * h_s + 1) * D) + lane;
            const f32x4* pre = (const f32x4*)(npre + (size_t)(h_l * 3 + h_s) * D) + lane;
#pragma unroll
            for (int j = 0; j < 4; ++j) { A2[j] = pre[64 * j] * (scale[64 * j] + 1.0f); A3[j] = shift[64 * j]; } }
        f32x4 v0[4], v1[4], v2[4], v3[4]; u32x2 xb0[4], xb1[4], xb2[4], xb3[4], yb0[4], yb1[4], yb2[4], yb3[4];
#define NP_LOAD(ROW_, V_, XB_, YB_) do { \
            if (in_f32) { const f32x4* xr_ = (const f32x4*)(xin + (size_t)(ROW_) * D * 4) + lane; _Pragma("unroll") for (int j = 0; j < 4; ++j) V_[j] = xr_[64 * j]; } \
            else { const u32x2* xr_ = (const u32x2*)(xin + (size_t)(ROW_) * D * 2) + lane; _Pragma("unroll") for (int j = 0; j < 4; ++j) XB_[j] = xr_[64 * j]; } \
            if (upd) { const u32x2* yr_ = (const u32x2*)(y + (size_t)(ROW_) * D) + lane; _Pragma("unroll") for (int j = 0; j < 4; ++j) YB_[j] = yr_[64 * j]; } } while (0)
#define NP_PROC(ROW_, V_, XB_, YB_) do { \
            if (!in_f32) { _Pragma("unroll") for (int j = 0; j < 4; ++j) V_[j] = (f32x4){h_lo(XB_[j].x), h_hi(XB_[j].x), h_lo(XB_[j].y), h_hi(XB_[j].y)}; } \
            if (upd) { \
                f32x4 yv[4]; float ss = 0.f; \
                _Pragma("unroll") for (int j = 0; j < 4; ++j) { const u32x2 w = YB_[j]; yv[j] = (f32x4){bf_lo(w.x), bf_hi(w.x), bf_lo(w.y), bf_hi(w.y)}; ss += (yv[j][0] * yv[j][0] + yv[j][1] * yv[j][1]) + (yv[j][2] * yv[j][2] + yv[j][3] * yv[j][3]); } \
                const float rstd = rsqrtf(wave_sum(ss) * (1.0f / D) + EPS); \
                _Pragma("unroll") for (int j = 0; j < 4; ++j) V_[j] += A1[j] * yv[j] * rstd; \
                if (out_f32) { f32x4* xo = (f32x4*)(xout + (size_t)(ROW_) * D * 4) + lane; _Pragma("unroll") for (int j = 0; j < 4; ++j) xo[64 * j] = V_[j]; } \
                else { u32x2* xo = (u32x2*)(xout + (size_t)(ROW_) * D * 2) + lane; _Pragma("unroll") for (int j = 0; j < 4; ++j) { u32x2 w; w.x = pk_h2(V_[j][0], V_[j][1]); w.y = pk_h2(V_[j][2], V_[j][3]); xo[64 * j] = w; } } \
            } \
            if (hh) { \
                float ss = 0.f; \
                _Pragma("unroll") for (int j = 0; j < 4; ++j) ss += (V_[j][0] * V_[j][0] + V_[j][1] * V_[j][1]) + (V_[j][2] * V_[j][2] + V_[j][3] * V_[j][3]); \
                const float rstd = rsqrtf(wave_sum(ss) * (1.0f / D) + EPS); \
                u32x2* ho = (u32x2*)(h + (size_t)(ROW_) * D) + lane; \
                _Pragma("unroll") for (int j = 0; j < 4; ++j) { const f32x4 o = V_[j] * rstd * A2[j] + A3[j]; u32x2 w; w.x = cvt_pk_bf16(o[0], o[1]); w.y = cvt_pk_bf16(o[2], o[3]); ho[64 * j] = w; } \
            } } while (0)
#pragma unroll
        for (int j = 0; j < 4; ++j) { v0[j] = (f32x4){0.f, 0.f, 0.f, 0.f}; v1[j] = v0[j]; v2[j] = v0[j]; v3[j] = v0[j]; xb0[j] = (u32x2){0u, 0u}; xb1[j] = xb0[j]; xb2[j] = xb0[j]; xb3[j] = xb0[j]; yb0[j] = xb0[j]; yb1[j] = xb0[j]; yb2[j] = xb0[j]; yb3[j] = xb0[j]; }
        const int rbeg = aff ? 4096 * ax + 128 * aj + 16 * wave : b * SEQ + gw, rend = aff ? rbeg + 16 : (b + 1) * SEQ, rstep = aff ? 1 : NGW;
        if (rbeg < rend) NP_LOAD(rbeg, v0, xb0, yb0);
        if (rbeg + rstep < rend) NP_LOAD(rbeg + rstep, v1, xb1, yb1);
        if (rbeg + 2 * rstep < rend) NP_LOAD(rbeg + 2 * rstep, v2, xb2, yb2);
        for (int row = rbeg; row < rend; row += 4 * rstep) {
            if (row + 3 * rstep < rend) NP_LOAD(row + 3 * rstep, v3, xb3, yb3);
            NP_PROC(row, v0, xb0, yb0);
            if (row + 4 * rstep < rend) NP_LOAD(row + 4 * rstep, v0, xb0, yb0);
            if (row + rstep < rend) NP_PROC(row + rstep, v1, xb1, yb1);
            if (row + 5 * rstep < rend) NP_LOAD(row + 5 * rstep, v1, xb1, yb1);
            if (row + 2 * rstep < rend) NP_PROC(row + 2 * rstep, v2, xb2, yb2);
            if (row + 6 * rstep < rend) NP_LOAD(row + 6 * rstep, v2, xb2, yb2);
            if (row + 3 * rstep < rend) NP_PROC(row + 3 * rstep, v3, xb3, yb3);
        }
#undef NP_PROC
#undef NP_LOAD
    }
}

#define MFMA16(a, b, c) __builtin_amdgcn_mfma_f32_16x16x32_bf16((a), (b), (c), 0, 0, 0)
__device__ __forceinline__ void hgrn_phase(LAS unsigned char* lds, const bool full, const int dmode = 0) {
    const bool dummy = dmode != 0;
    const CAS Params* kpar = KP(); unsigned char* ws = kpar->ws; const float* onorm = kpar->in[10];
    constexpr int QM = 0, KM = 17408, QI = 34816, STO = 52224, PP = 87040, VTO = 96256, KDT = 114688, SEG = 133120, BL = 137216, RED = 137728;
    const int tid = TID(), lane = tid & 63, wave = __builtin_amdgcn_readfirstlane(tid >> 6), fr = lane & 15, fq = lane >> 4;
    const int kp = tid & 63, sg = tid >> 6;
    const bf16_t* qs = (const bf16_t*)(ws + OFF_R1); const bf16_t* kkp = (const bf16_t*)(ws + OFF_R1 + 64 * MiB); const bf16_t* ivp = (const bf16_t*)(ws + OFF_R1 + 128 * MiB);
    const bf16_t* lfp = (const bf16_t*)(ws + OFF_R2);   const bf16_t* gsp = (const bf16_t*)(ws + OFF_R2 + 128 * MiB);
    bf16_t* og = (bf16_t*)(ws + OFF_R1);
    f32x4* Lbuf = (f32x4*)(ws + OFF_YH); float* logDbuf = (float*)(ws + OFF_YH + 16 * MiB);
    LAS float* segs = (LAS float*)(lds + SEG); LAS float* blv = (LAS float*)(lds + BL); LAS float* red = (LAS float*)(lds + RED);
    const int vcu_ = __builtin_amdgcn_readfirstlane((int)*(volatile LAS unsigned*)(lds + LDS_BYTES - 8));
    const int item0 = gridDim.x == 256 ? (((vcu_ & 7) >> 2) * 8 + (vcu_ >> 5)) * 16 + 4 * (vcu_ & 3) + ((vcu_ >> 3) & 3) : BID();
    for (int item = item0; item < 256; item += gridDim.x) {
        const int bh = item >> 4, sc = item & 15, b = bh >> 3, hd = bh & 7;
        const size_t tok0 = (size_t)b * SEQ + (size_t)sc * 1024;
        f32x4 S[8];
#pragma unroll
        for (int vt = 0; vt < 8; ++vt) S[vt] = (f32x4){0.f, 0.f, 0.f, 0.f};
        f32x2v logD2 = (f32x2v){0.f, 0.f};
        __syncthreads();
        if (full) {
            f32x4 suff = (f32x4){0.f, 0.f, 0.f, 0.f};
            f32x4 La[8], Lb[8], lda, ldb;
#define HG_LLOAD(I_, L_, LD_) do { const int pit_ = bh * 16 + (I_); LD_ = *(const f32x4*)(logDbuf + pit_ * 128 + 16 * wave + fq * 4); \
                _Pragma("unroll") for (int vt = 0; vt < 8; ++vt) L_[vt] = Lbuf[(size_t)(pit_ * 8 + vt) * 512 + tid]; } while (0)
#pragma unroll
            for (int vt = 0; vt < 8; ++vt) { La[vt] = (f32x4){0.f, 0.f, 0.f, 0.f}; Lb[vt] = La[vt]; }
            lda = La[0]; ldb = La[0];
            if (sc > 0) HG_LLOAD(sc - 1, La, lda);
            for (int i = sc - 1; i >= 0; --i) {
                if (i > 0) HG_LLOAD(i - 1, Lb, ldb);
                asm volatile("" : "+v"(La[0]), "+v"(La[1]), "+v"(La[2]), "+v"(La[3]), "+v"(La[4]), "+v"(La[5]), "+v"(La[6]), "+v"(La[7]), "+v"(lda));
                const f32x4 pk = (f32x4){fexp(suff[0]), fexp(suff[1]), fexp(suff[2]), fexp(suff[3])};
#pragma unroll
                for (int vt = 0; vt < 8; ++vt) { S[vt] += La[vt] * pk; La[vt] = Lb[vt]; }
                suff += lda; lda = ldb; }
#undef HG_LLOAD
#pragma unroll
            for (int vt = 0; vt < 8; ++vt) { u32x2 w; w.x = cvt_pk_bf16(S[vt][0], S[vt][1]); w.y = cvt_pk_bf16(S[vt][2], S[vt][3]);
                *(LAS u32x2*)(lds + STO + (16 * vt + fr) * 272 + (16 * wave + fq * 4) * 2) = w; }
        }
        f32x2v lf2[8]; unsigned v2[8], q2[8];
#define HG_LOAD(CI) do { const size_t gb_ = (tok0 + (size_t)(CI) * 64 + sg * 8) * 1024 + hd * 128 + 2 * kp; \
            _Pragma("unroll") for (int i = 0; i < 8; ++i) { { const unsigned lw_ = *(const unsigned*)(lfp + gb_ + (size_t)i * 1024); lf2[i] = (f32x2v){h_lo(lw_), h_hi(lw_)}; } v2[i] = *(const unsigned*)(ivp + gb_ + (size_t)i * 1024); \
                q2[i] = full ? *(const unsigned*)(qs + gb_ + (size_t)i * 1024) : 0u; } } while (0)
        f32x4 onv[4];
#pragma unroll
        for (int j = 0; j < 4; ++j) onv[j] = *(const f32x4*)(onorm + 16 * ((wave >> 2) * 4 + j) + fq * 4);
        HG_LOAD(0);
        for (int ci = 0; ci < 16; ++ci) {
            const size_t t0 = tok0 + (size_t)ci * 64;
            f32x2v run = (f32x2v){0.f, 0.f}, kraw[8];
#pragma unroll
            for (int i = 0; i < 8; ++i) { kraw[i] = (f32x2v){1.f - fexp(lf2[i].x), 1.f - fexp(lf2[i].y)}; run += lf2[i]; lf2[i] = run; }
            *(LAS f32x2v*)(segs + sg * 128 + 2 * kp) = run;
            LDS_BARRIER();
            f32x2v prefix = (f32x2v){0.f, 0.f}, bmid = prefix, blast = prefix;
#pragma unroll
            for (int s_ = 0; s_ < 8; ++s_) { const f32x2v sv = *(const LAS f32x2v*)(segs + s_ * 128 + 2 * kp); if (s_ < sg) prefix += sv; if (s_ < 4) bmid += sv; blast += sv; }
            if (sg == 0) { *(LAS f32x2v*)(blv + 2 * kp) = blast; logD2 += blast; }
            if (dmode != 3) {
                unsigned kda[4], kdb[4], vta[4], vtb[4];
#pragma unroll
                for (int i = 0; i < 8; i += 2) {
                    const f32x2v bb0 = prefix + lf2[i], bb1 = prefix + lf2[i + 1];
                    const float ka0 = kraw[i].x, kb0 = kraw[i].y, ka1 = kraw[i + 1].x, kb1 = kraw[i + 1].y;
                    kda[i >> 1] = cvt_pk_bf16(ka0 * fexp(blast.x - bb0.x), ka1 * fexp(blast.x - bb1.x));
                    kdb[i >> 1] = cvt_pk_bf16(kb0 * fexp(blast.y - bb0.y), kb1 * fexp(blast.y - bb1.y));
                    vta[i >> 1] = (v2[i] & 0xffffu) | (v2[i + 1] << 16);
                    vtb[i >> 1] = (v2[i] >> 16) | (v2[i + 1] & 0xffff0000u);
                    if (full) {
                        const int ta = sg * 8 + i;
                        { const float qa = bf_lo(q2[i]), qb = bf_hi(q2[i]);
                          *(LAS unsigned*)(lds + QM + ta * 272 + kp * 4) = cvt_pk_bf16(qa * fexp(bb0.x - bmid.x), qb * fexp(bb0.y - bmid.y));
                          *(LAS unsigned*)(lds + KM + ta * 272 + kp * 4) = cvt_pk_bf16(ka0 * fexp(bmid.x - bb0.x), kb0 * fexp(bmid.y - bb0.y));
                          *(LAS unsigned*)(lds + QI + ta * 272 + kp * 4) = cvt_pk_bf16(qa * fexp(bb0.x), qb * fexp(bb0.y)); }
                        { const float qa = bf_lo(q2[i + 1]), qb = bf_hi(q2[i + 1]);
                          *(LAS unsigned*)(lds + QM + (ta + 1) * 272 + kp * 4) = cvt_pk_bf16(qa * fexp(bb1.x - bmid.x), qb * fexp(bb1.y - bmid.y));
                          *(LAS unsigned*)(lds + KM + (ta + 1) * 272 + kp * 4) = cvt_pk_bf16(ka1 * fexp(bmid.x - bb1.x), kb1 * fexp(bmid.y - bb1.y));
                          *(LAS unsigned*)(lds + QI + (ta + 1) * 272 + kp * 4) = cvt_pk_bf16(qa * fexp(bb1.x), qb * fexp(bb1.y)); }
                    }
                }
                *(LAS u32x4*)(lds + KDT + (2 * kp) * 144 + sg * 16) = (u32x4){kda[0], kda[1], kda[2], kda[3]}; *(LAS u32x4*)(lds + KDT + (2 * kp + 1) * 144 + sg * 16) = (u32x4){kdb[0], kdb[1], kdb[2], kdb[3]};
                *(LAS u32x4*)(lds + VTO + (2 * kp) * 144 + sg * 16) = (u32x4){vta[0], vta[1], vta[2], vta[3]}; *(LAS u32x4*)(lds + VTO + (2 * kp + 1) * 144 + sg * 16) = (u32x4){vtb[0], vtb[1], vtb[2], vtb[3]};
            }
            LDS_BARRIER();
            if (ci + 1 < 16) HG_LOAD(ci + 1);
            if (dmode == 2) continue;
            f32x4 O[4];
            const int tt = wave & 3, vh = wave >> 2;
            const size_t orow = (t0 + 16 * tt + fr) * 1024 + hd * 128;
            u32x2 g2[4];
#pragma unroll
            for (int j = 0; j < 4; ++j) g2[j] = full ? *(const u32x2*)(gsp + orow + 16 * (vh * 4 + j) + fq * 4) : (u32x2){0u, 0u};
#define FRAG(BASE_, ROW_, STRIDE_, KS_) (*(const LAS bf16x8*)(lds + (BASE_) + (ROW_) * (STRIDE_) + ((KS_) * 32 + fq * 8) * 2))
#define PIN5(a_, b_, c_, d_, e_) asm volatile("" : "+v"(a_), "+v"(b_), "+v"(c_), "+v"(d_), "+v"(e_))
#define PIN4(a_, b_, c_, d_) asm volatile("" : "+v"(a_), "+v"(b_), "+v"(c_), "+v"(d_))
            if (full) {
                { const int ta = wave >> 1, st0 = (wave & 1) * 2;
                  bf16x8 yq[4], xk0[4], xk1[4];
#pragma unroll
                  for (int ks = 0; ks < 4; ++ks) { yq[ks] = FRAG(QM, 16 * ta + fr, 272, ks); xk0[ks] = FRAG(KM, 16 * st0 + fr, 272, ks); xk1[ks] = FRAG(KM, 16 * (st0 + 1) + fr, 272, ks); }
                  PIN4(yq[0], yq[1], yq[2], yq[3]); PIN4(xk0[0], xk0[1], xk0[2], xk0[3]); PIN4(xk1[0], xk1[1], xk1[2], xk1[3]);
#pragma unroll
                  for (int e = 0; e < 2; ++e) { const int st = st0 + e;
                    f32x4 a = (f32x4){0.f, 0.f, 0.f, 0.f};
                    if (st <= ta) {
#pragma unroll
                        for (int ks = 0; ks < 4; ++ks) a = MFMA16(e ? xk1[ks] : xk0[ks], yq[ks], a);
                        const int tg = 16 * ta + fr, sgl = 16 * st + fq * 4;
#pragma unroll
                        for (int r = 0; r < 4; ++r) a[r] = (sgl + r <= tg) ? a[r] : 0.f;
                    }
                    u32x2 w; w.x = cvt_pk_bf16(a[0], a[1]); w.y = cvt_pk_bf16(a[2], a[3]);
                    *(LAS u32x2*)(lds + PP + (16 * ta + fr) * 144 + (16 * st + fq * 4) * 2) = w; } }
#pragma unroll
                for (int j = 0; j < 4; ++j) O[j] = (f32x4){0.f, 0.f, 0.f, 0.f};
                { bf16x8 fy[2], fx[2][4];
                  fy[0] = FRAG(QI, 16 * tt + fr, 272, 0);
#pragma unroll
                  for (int j = 0; j < 4; ++j) fx[0][j] = FRAG(STO, 16 * (vh * 4 + j) + fr, 272, 0);
#pragma unroll
                  for (int ks = 0; ks < 4; ++ks) { const int cb = ks & 1, nb = cb ^ 1;
                    if (ks < 3) { fy[nb] = FRAG(QI, 16 * tt + fr, 272, ks + 1);
#pragma unroll
                        for (int j = 0; j < 4; ++j) fx[nb][j] = FRAG(STO, 16 * (vh * 4 + j) + fr, 272, ks + 1); }
                    PIN5(fy[cb], fx[cb][0], fx[cb][1], fx[cb][2], fx[cb][3]);
#pragma unroll
                    for (int j = 0; j < 4; ++j) O[j] = MFMA16(fx[cb][j], fy[cb], O[j]); } }
                LDS_BARRIER();
            }
            { bf16x8 xkd[2], yp[2], yb[2][4];
#pragma unroll
              for (int ks = 0; ks < 2; ++ks) { xkd[ks] = FRAG(KDT, 16 * wave + fr, 144, ks); yp[ks] = full ? FRAG(PP, 16 * tt + fr, 144, ks) : xkd[ks]; }
#pragma unroll
              for (int j = 0; j < 4; ++j) yb[0][j] = FRAG(VTO, 16 * j + fr, 144, 0);
              const f32x4 bl4 = *(const LAS f32x4*)(lds + BL + (16 * wave + fq * 4) * 4);
              const f32x4 dk = (f32x4){fexp(bl4[0]), fexp(bl4[1]), fexp(bl4[2]), fexp(bl4[3])};
#pragma unroll
              for (int vt = 0; vt < 8; ++vt) S[vt] = S[vt] * dk;
              PIN4(xkd[0], xkd[1], yp[0], yp[1]);
#pragma unroll
              for (int bi = 0; bi < 4; ++bi) { const int ks = bi >> 1, hf = bi & 1, cb = bi & 1, nb = cb ^ 1;
                  if (bi < 3) {
#pragma unroll
                      for (int j = 0; j < 4; ++j) yb[nb][j] = FRAG(VTO, 16 * (((bi + 1) & 1) * 4 + j) + fr, 144, (bi + 1) >> 1); }
                  PIN4(yb[cb][0], yb[cb][1], yb[cb][2], yb[cb][3]);
                  if (full && hf == vh) {
#pragma unroll
                      for (int j = 0; j < 4; ++j) O[j] = MFMA16(yb[cb][j], yp[ks], O[j]); }
#pragma unroll
                  for (int j = 0; j < 4; ++j) S[hf * 4 + j] = MFMA16(xkd[ks], yb[cb][j], S[hf * 4 + j]); } }
#undef FRAG
#undef PIN5
#undef PIN4
            if (full) {
#pragma unroll
                for (int vt = 0; vt < 8; ++vt) { u32x2 w; w.x = cvt_pk_bf16(S[vt][0], S[vt][1]); w.y = cvt_pk_bf16(S[vt][2], S[vt][3]);
                    *(LAS u32x2*)(lds + STO + (16 * vt + fr) * 272 + (16 * wave + fq * 4) * 2) = w; }
                float ssq = 0.f;
#pragma unroll
                for (int j = 0; j < 4; ++j) ssq += (O[j][0] * O[j][0] + O[j][1] * O[j][1]) + (O[j][2] * O[j][2] + O[j][3] * O[j][3]);
                ssq += __shfl_xor(ssq, 16); ssq += __shfl_xor(ssq, 32);
                if (fq == 0) red[vh * 64 + 16 * tt + fr] = ssq;
                LDS_BARRIER();
                const float rstd = rsqrtf((red[16 * tt + fr] + red[64 + 16 * tt + fr]) * (1.0f / 128.0f) + EPS);
#pragma unroll
                for (int j = 0; j < 4; ++j) { const int v0 = 16 * (vh * 4 + j) + fq * 4;
                    const f32x4 o = O[j] * rstd * onv[j] * (f32x4){bf_lo(g2[j].x), bf_hi(g2[j].x), bf_lo(g2[j].y), bf_hi(g2[j].y)};
                    u32x2 w; w.x = cvt_pk_bf16(o[0], o[1]); w.y = cvt_pk_bf16(o[2], o[3]);
                    if (!dummy) *(u32x2*)(og + orow + v0) = w; }
            }
        }
        if (!full) {
#pragma unroll
            for (int vt = 0; vt < 8; ++vt) Lbuf[(size_t)(item * 8 + vt) * 512 + tid] = S[vt];
            if (sg == 0) *(f32x2v*)(logDbuf + item * 128 + 2 * kp) = logD2;
        }
    }
}

__device__ __forceinline__ void spatial_phase(LAS unsigned char* lds, const int dmode = 0) {
    const bool dummy = dmode != 0;
    const CAS Params* kp = KP(); unsigned char* ws = kp->ws; const float* lng = kp->in[14]; const float* lnb = kp->in[15]; const float* wsp = kp->in[16]; const float* bsp = kp->in[17];
    constexpr int WM = 0, VN0 = 34816, VNH = 52224, MU = 139264;
    const int tid = TID(), lane = tid & 63, wave = __builtin_amdgcn_readfirstlane(tid >> 6), fr = lane & 15, fq = lane >> 4;
    bf16_t* u = (bf16_t*)(ws + OFF_R1); const bf16_t* vT = (const bf16_t*)(ws + OFF_R2); const f32x2v* part = (const f32x2v*)(ws + OFF_PART);
    const int c = BID(), G = (int)gridDim.x;
    const int vcu_ = __builtin_amdgcn_readfirstlane((int)*(volatile LAS unsigned*)(lds + LDS_BYTES - 8));
    const bool aff = G == 256;
    const int g = aff ? ((vcu_ >> 3) & 7) : (c & 7), n0 = aff ? 32 * (vcu_ & 7) + (vcu_ >> 6) : (c >> 3), nstep = aff ? 4 : ((G + 7 - g) >> 3);
    int nitems = aff ? 8 : (n0 < 256 ? (256 - n0 + nstep - 1) / nstep : 0);
    if (nitems > 8) nitems = 8;
    if (nitems == 0) return;
    __syncthreads();
    for (int e = tid; e < nitems * 128; e += 512) { const int it = e >> 7, tk = e & 127; const size_t tok = (size_t)(n0 + it * nstep) * 128 + tk;
        float s_ = 0.f, q_ = 0.f;
#pragma unroll
        for (int pi = 0; pi < 24; ++pi) { const f32x2v v_ = part[(size_t)pi * T + tok]; s_ += v_.x; q_ += v_.y; }
        const float m_ = s_ * (1.0f / 3072.0f), var_ = q_ * (1.0f / 3072.0f) - m_ * m_;
        LAS float* mu_ = (LAS float*)(lds + MU + it * 1024); mu_[tk] = m_; mu_[128 + tk] = rsqrtf(var_ + EPS); }
    f32x4 wst[8];
#pragma unroll
    for (int i = 0; i < 8; ++i) { const int idx = tid + 512 * i, t = idx >> 5, s4 = (idx & 31) * 4; wst[i] = *(const f32x4*)(wsp + (size_t)(g * 128 + t) * 128 + s4); }
    asm volatile("" : "+v"(wst[0]), "+v"(wst[1]), "+v"(wst[2]), "+v"(wst[3]), "+v"(wst[4]), "+v"(wst[5]), "+v"(wst[6]), "+v"(wst[7]));
#pragma unroll
    for (int i = 0; i < 8; ++i) { const int idx = tid + 512 * i, t = idx >> 5, s4 = (idx & 31) * 4;
        const f32x4 w = wst[i];
        u32x2 o; o.x = cvt_pk_bf16(s4 + 0 <= t ? w[0] : 0.f, s4 + 1 <= t ? w[1] : 0.f); o.y = cvt_pk_bf16(s4 + 2 <= t ? w[2] : 0.f, s4 + 3 <= t ? w[3] : 0.f);
        *(LAS u32x2*)(lds + WM + t * 272 + s4 * 2) = o; }
    u32x4 rawA[6], rawB[6]; float lgA[6], lgB[6], lbA[6], lbB[6];
#define SP_LOAD(HI_, RAW_, LG_, LB_) do { const int n_ = n0 + ((HI_) >> 1) * nstep, h_ = (HI_) & 1; _Pragma("unroll") for (int i = 0; i < 6; ++i) { const int piece = tid + 512 * i, cl = piece >> 4, s8 = (piece & 15) * 8; const int ch = g * 384 + h_ * 192 + cl; \
        RAW_[i] = *(const u32x4*)(vT + ((size_t)n_ * 3072 + ch) * 128 + s8); LG_[i] = lng[ch]; LB_[i] = lnb[ch]; } } while (0)
    const int nst = 2 * nitems;
    SP_LOAD(0, rawA, lgA, lbA);
    SP_LOAD(1, rawB, lgB, lbB);
    const float bs = bsp[g * 128 + 16 * wave + fr];
    const int nks = (wave >> 1) + 1;
    __syncthreads();
#define SP_STAGE(HI_, RAW_, LG_, LB_) do { \
        const int it_ = (HI_) >> 1, half_ = (HI_) & 1, n_ = n0 + it_ * nstep; \
        if (dmode != 3) { const LAS float* mu = (const LAS float*)(lds + MU + it_ * 1024); const int s8 = (tid & 15) * 8;     \
          const f32x4 m0 = *(const LAS f32x4*)(mu + s8), m1 = *(const LAS f32x4*)(mu + s8 + 4), r0 = *(const LAS f32x4*)(mu + 128 + s8), r1 = *(const LAS f32x4*)(mu + 128 + s8 + 4); \
          _Pragma("unroll") for (int i = 0; i < 6; ++i) { const int piece = tid + 512 * i, cl = piece >> 4; \
            const int j = cl & 31, lrow = (cl & ~31) + ((j >> 2) & 1) * 16 + (j >> 3) * 4 + (j & 3); \
            f32x4 a = (f32x4){bf_lo(RAW_[i].x), bf_hi(RAW_[i].x), bf_lo(RAW_[i].y), bf_hi(RAW_[i].y)}, bq = (f32x4){bf_lo(RAW_[i].z), bf_hi(RAW_[i].z), bf_lo(RAW_[i].w), bf_hi(RAW_[i].w)}; \
            a = (a - m0) * r0 * LG_[i] + LB_[i]; bq = (bq - m1) * r1 * LG_[i] + LB_[i]; \
            *(LAS u32x4*)(lds + VN0 + half_ * VNH + lrow * 272 + s8 * 2) = pack8(a, bq); } } \
        LDS_BARRIER(); \
        if ((HI_) + 2 < nst) SP_LOAD((HI_) + 2, RAW_, LG_, LB_); \
        bf16_t* ub = u + ((size_t)n_ * 128 + 16 * wave + fr) * 3072 + g * 384 + half_ * 192 + fq * 8; \
        bf16x8 yf[4]; \
        _Pragma("unroll") for (int ks = 0; ks < 4; ++ks) yf[ks] = *(const LAS bf16x8*)(lds + WM + (16 * wave + fr) * 272 + (ks * 32 + fq * 8) * 2); \
        if (dmode != 2) { \
          bf16x8 xa[2][4], xb[2][4]; \
          _Pragma("unroll") for (int ks = 0; ks < 4; ++ks) { xa[0][ks] = yf[ks]; xb[0][ks] = yf[ks]; xa[1][ks] = yf[ks]; xb[1][ks] = yf[ks]; } \
          _Pragma("unroll") for (int ks = 0; ks < 4; ++ks) if (ks < nks) { xa[0][ks] = *(const LAS bf16x8*)(lds + VN0 + half_ * VNH + fr * 272 + (ks * 32 + fq * 8) * 2); xb[0][ks] = *(const LAS bf16x8*)(lds + VN0 + half_ * VNH + (16 + fr) * 272 + (ks * 32 + fq * 8) * 2); } \
          _Pragma("unroll") for (int p2 = 0; p2 < 6; ++p2) { const int cb = p2 & 1, nb = cb ^ 1; \
            if (p2 < 5) { _Pragma("unroll") for (int ks = 0; ks < 4; ++ks) if (ks < nks) { \
                xa[nb][ks] = *(const LAS bf16x8*)(lds + VN0 + half_ * VNH + (32 * (p2 + 1) + fr) * 272 + (ks * 32 + fq * 8) * 2); \
                xb[nb][ks] = *(const LAS bf16x8*)(lds + VN0 + half_ * VNH + (32 * (p2 + 1) + 16 + fr) * 272 + (ks * 32 + fq * 8) * 2); } } \
            asm volatile("" : "+v"(xa[cb][0]), "+v"(xa[cb][1]), "+v"(xa[cb][2]), "+v"(xa[cb][3])); asm volatile("" : "+v"(xb[cb][0]), "+v"(xb[cb][1]), "+v"(xb[cb][2]), "+v"(xb[cb][3])); \
            f32x4 a0 = (f32x4){0.f, 0.f, 0.f, 0.f}, a1 = a0; \
            _Pragma("unroll") for (int ks = 0; ks < 4; ++ks) if (ks < nks) { a0 = MFMA16(xa[cb][ks], yf[ks], a0); a1 = MFMA16(xb[cb][ks], yf[ks], a1); } \
            if (!dummy) *(u32x4*)(ub + 32 * p2) = pack8(a0 + bs, a1 + bs); } } \
    } while (0)
    for (int hi = 0; hi < nst; hi += 2) {
        SP_STAGE(hi, rawA, lgA, lbA);
        SP_STAGE(hi + 1, rawB, lgB, lbB);
    }
#undef SP_STAGE
#undef SP_LOAD
}

#ifndef GEMM_ALIGN
#define GEMM_ALIGN true
#endif
#ifndef GEMM_SP2
#define GEMM_SP2 true
#endif
enum { PT_PREP0 = 0, PT_NORM, PT_G1, PT_G2, PT_GPROJ, PT_H1, PT_H2, PT_GHOUT, PT_GV, PT_SPATIAL, PT_GU, PT_GMOUT };
constexpr int N_PHASES = 24;
__global__ void __launch_bounds__(512, 2) mega(Params p_unused) {
    extern __shared__ __attribute__((aligned(16))) unsigned char smem[];
    LAS unsigned char* lds = (LAS unsigned char*)smem;
    cg::grid_group grid = cg::this_grid();
    const int ph_lo = KP()->ph_lo, ph_hi = KP()->ph_hi;
    volatile LAS unsigned* xst = (volatile LAS unsigned*)(lds + LDS_BYTES - 16);
    if (threadIdx.x == 0) { xst[0] = 0u; xst[1] = 0u; xst[2] = blockIdx.x; xst[3] = 0u; }
    __syncthreads();
    XcdBarrier xb; xb.bar = (unsigned*)(KP()->ws + OFF_BAR); xb.x = xb_xcc_id(); xb.st = xst;
    if (ph_hi - ph_lo > 1) {
        xb = xcd_barrier_post((unsigned*)(KP()->ws + OFF_BAR), xst);
        if (threadIdx.x == 0) xst[3] = xb_add(&xb.bar[4 * xb.x], 1u);
    }
    for (int ph = ph_lo; ph < ph_hi; ++ph) {
        int type, a0 = 0, a1 = 0, a2 = -1, a3 = 0, a4 = 0;
        switch (ph) {
            case 0: type = PT_PREP0; break;
            case 1: type = PT_NORM; a0 = -1; a2 = 0; a3 = 0; break;
            case 2: type = PT_G1; a0 = 0; a1 = 0; break;
            case 3: type = PT_G2; a0 = 0; a1 = 0; break;
            case 4: type = PT_NORM; a0 = 0; a1 = 0; a2 = 0; a3 = 1; break;
            case 5: type = PT_GPROJ; break;
            case 6: type = PT_H1; break;
            case 7: type = PT_H2; break;
            case 8: type = PT_GHOUT; break;
            case 9: type = PT_NORM; a0 = 0; a1 = 1; a2 = 0; a3 = 2; break;
            case 10: type = PT_G1; a0 = 0; a1 = 1; break;
            case 11: type = PT_G2; a0 = 0; a1 = 1; break;
            case 12: type = PT_NORM; a0 = 0; a1 = 2; a2 = 1; a3 = 0; a4 = 1; break;
            case 13: type = PT_G1; a0 = 1; a1 = 0; break;
            case 14: type = PT_G2; a0 = 1; a1 = 0; break;
            case 15: type = PT_NORM; a0 = 1; a1 = 0; a2 = 1; a3 = 1; break;
            case 16: type = PT_GV; break;
            case 17: type = PT_SPATIAL; break;
            case 18: type = PT_GU; break;
            case 19: type = PT_GMOUT; break;
            case 20: type = PT_NORM; a0 = 1; a1 = 1; a2 = 1; a3 = 2; break;
            case 21: type = PT_G1; a0 = 1; a1 = 1; break;
            case 22: type = PT_G2; a0 = 1; a1 = 1; break;
            default: type = PT_NORM; a0 = 1; a1 = 2; a2 = -1; break;
        }
#ifndef EN
#define EN 0xff
#endif
#ifndef PROBE
#define PROBE 0
#endif
        for (int rep = 0; rep < (PROBE == 4 ? 2 : 1); ++rep) {
        if ((EN & 1) && (type == PT_PREP0 || (type == PT_NORM && a4))) prep_weights(lds, type == PT_PREP0 ? 0 : 1);
        if ((EN & 2) && type == PT_PREP0) mod_gemv(lds);
        }
        const int xsrc = ph <= 4 ? 0 : (ph == N_PHASES - 1 ? 2 : 1), xdst = ph == N_PHASES - 1 ? 3 : (ph == 20 ? 2 : 1);
        if (PROBE == 3 && type == PT_NORM) norm_phase(a0, a1, a2, a3, xsrc, xdst, true, __builtin_amdgcn_readfirstlane((int)xst[2]));
        if ((EN & 4) && type == PT_NORM) norm_phase(a0, a1, a2, a3, xsrc, xdst, false, __builtin_amdgcn_readfirstlane((int)xst[2]));
        for (int rep = 0; rep < (((PROBE == 2 && type == PT_H1) || ((PROBE == 5 || PROBE == 13 || PROBE == 14) && type == PT_H2)) ? 2 : 1); ++rep)
        if ((EN & 8) && (type == PT_H1 || type == PT_H2)) hgrn_phase(lds, type == PT_H2, (rep == 0 && type == PT_H2) ? (PROBE == 5 ? 1 : PROBE == 13 ? 2 : PROBE == 14 ? 3 : 0) : 0);
        for (int rep = 0; rep < ((PROBE == 6 || PROBE == 11 || PROBE == 12) ? 2 : 1); ++rep)
        if ((EN & 16) && type == PT_SPATIAL) spatial_phase(lds, rep == 0 ? (PROBE == 6 ? 1 : PROBE == 11 ? 2 : PROBE == 12 ? 3 : 0) : 0);
        if ((EN & 32) && (type == PT_G1 || type == PT_G2 || type == PT_GPROJ || type == PT_GHOUT || type == PT_GV || type == PT_GU || type == PT_GMOUT)) {
            const int ncall = 1;
            for (int cj = 0; cj < ncall * (((PROBE == 1 && type != PT_GU) || PROBE == 8 || PROBE == 10) ? 2 : 1); ++cj) { const int ci = cj % ncall;
                unsigned char* ws = KP()->ws;
                const bf16_t* Wb = (const bf16_t*)(ws + OFF_W);
                pg8::Gemm g; Epi E; E.mode_in = 0;
                g.A = (const bf16_t*)(ws + OFF_YH); g.M = T; g.N = D; g.K = D; g.Bt = Wb;
                if (type == PT_G1) { g.Bt = Wb + (a1 ? W_IN1 : W_IN0); g.N = 2 * DFF; g.K = D; E.mode_in = 1; }
                else if (type == PT_G2) { g.A = (const bf16_t*)(ws + OFF_R1); g.Bt = Wb + (a1 ? W_OUT1 : W_OUT0); g.N = D; g.K = DFF; }
                else if (type == PT_GPROJ) { g.Bt = Wb + W_X; g.N = 4096; g.K = D; E.mode_in = 2; }
                else if (type == PT_GHOUT) { g.A = (const bf16_t*)(ws + OFF_R1); g.Bt = Wb + W_HGOUT; g.N = D; g.K = D; }
                else if (type == PT_GMOUT) { g.A = (const bf16_t*)(ws + OFF_R1); g.Bt = Wb + W_GMOUT; g.N = D; g.K = 3072; }
                else if (type == PT_GU) { g.Bt = Wb + W_X; g.N = 3072; g.K = D; E.mode_in = 3; }
                else { g.A = Wb + W_X + (size_t)3072 * D; g.M = 3072; g.Bt = (const bf16_t*)(ws + OFF_YH); g.N = T; g.K = D; E.mode_in = 4; }
                if (PROBE == 8 && cj < ncall) E.mode_in = 7;
                if (PROBE == 10 && cj < ncall) E.mode_in |= 8;
                const int vcu = __builtin_amdgcn_readfirstlane((int)xst[2]);
                pg8::StaticOrder S; S.init(g.M, g.N, (int)gridDim.x, vcu);
                __syncthreads();
                pg8::gemm_phase<Epi, pg8::StaticOrder, GEMM_ALIGN, GEMM_SP2>(lds, g, S, E);
                __syncthreads();
            }
        }
        if (ph + 1 < ph_hi) {
            if (ph_hi > N_PHASES) grid.sync();
            xb.bar = (unsigned*)(KP()->ws + OFF_BAR); xcd_barrier(xb);
            if (PROBE == 7) { xcd_barrier(xb); xcd_barrier(xb); xcd_barrier(xb); }
            if (ph == ph_lo) {
                if (threadIdx.x == 0) { bool even = (gridDim.x & 7u) == 0u;
                    for (unsigned j = 0; j < 16; ++j) { const unsigned cnt = xb_ld(&xb.bar[XB_XCNT(j)]); even = even && (cnt == (j < 8 ? gridDim.x / 8u : 0u)); }
                    if (even && xb.x < 8u) xst[2] = xb.x + 8u * xst[3]; }
                __syncthreads();
            }
        }
    }
}

#ifndef MK_MULTI
#define MK_MULTI 0
#endif
extern "C" void kernel_launch(void* const* d_in, const int* in_sizes, int n_in, void* d_out, int out_size, void* d_ws, size_t ws_size, hipStream_t stream) {
    static int grid = 0;
    if (grid == 0) {
        if (n_in != 19 || in_sizes[0] != T * D || out_size != T * D || ws_size < WS_END) { fprintf(stderr, "kernel_launch: unexpected shapes / workspace: n_in %d in0 %d out %d ws %zu (need %zu)\n", n_in, n_in > 0 ? in_sizes[0] : -1, out_size, ws_size, (size_t)WS_END); grid = -1; return; }
        int dev = 0, cus = 0, per_cu = 0;
        if (hipGetDevice(&dev) != hipSuccess || hipDeviceGetAttribute(&cus, hipDeviceAttributeMultiprocessorCount, dev) != hipSuccess) { fprintf(stderr, "kernel_launch: device query failed\n"); grid = -1; return; }
        if (hipFuncSetAttribute((const void*)mega, hipFuncAttributeMaxDynamicSharedMemorySize, LDS_BYTES) != hipSuccess) { fprintf(stderr, "kernel_launch: hipFuncSetAttribute failed\n"); grid = -1; return; }
        if (hipOccupancyMaxActiveBlocksPerMultiprocessor(&per_cu, (const void*)mega, 512, LDS_BYTES) != hipSuccess || per_cu < 1) { fprintf(stderr, "kernel_launch: occupancy query says %d blocks per CU\n", per_cu); per_cu = 1; }
        (void)hipGetLastError();
        grid = cus;
    }
    if (grid < 0) return;
    if (hipMemsetAsync((unsigned char*)d_ws + OFF_BAR, 0, 16384, stream) != hipSuccess) { fprintf(stderr, "kernel_launch: hipMemsetAsync failed\n"); return; }
    Params p{};
    for (int i = 0; i < 19; ++i) p.in[i] = (const float*)d_in[i];
    p.out = (float*)d_out; p.ws = (unsigned char*)d_ws;
#if MK_MULTI
    for (int ph = 0; ph < N_PHASES; ++ph) { p.ph_lo = ph; p.ph_hi = ph + 1; hipLaunchKernelGGL(mega, dim3(grid), dim3(512), LDS_BYTES, stream, p); }
#else
    p.ph_lo = 0; p.ph_hi = N_PHASES;
    void* args[] = {&p};
    hipError_t e = hipLaunchCooperativeKernel((const void*)mega, dim3(grid), dim3(512), args, LDS_BYTES, stream);
    if (e != hipSuccess) fprintf(stderr, "kernel_launch: cooperative launch failed: %s (grid %d)\n", hipGetErrorString(e), grid);
#endif
}
```

```cpp
#include <hip/hip_runtime.h>
#include <hip/hip_cooperative_groups.h>
#include <cstdio>
#include <cstdint>
namespace cg = cooperative_groups;
__device__ __forceinline__ int TID() { int t = threadIdx.x; asm volatile("" : "+v"(t)); return t; }
__device__ __forceinline__ int BID() { int b = blockIdx.x; asm volatile("" : "+s"(b)); return b; }
#ifndef GEMM_WGM
#define GEMM_WGM 8
#endif
namespace pg8 {
#define PG8_LAS __attribute__((address_space(3)))
typedef unsigned short bf16_t;
typedef short bf16x8 __attribute__((ext_vector_type(8)));
typedef float f32x4 __attribute__((ext_vector_type(4)));
typedef unsigned u32x4 __attribute__((ext_vector_type(4)));
constexpr int BM = 256, BK = 64, HALF = 128, HTB = HALF * BK * 2  , STAGE_BYTES = 8 * HTB, NXCD = 8, WGM = GEMM_WGM;

__host__ __device__ __forceinline__ int lds_byte(int r, int c) { const int st = (r >> 4) * 2 + (c >> 5), rr = r & 15, cc = c & 31, ob = rr * 64 + cc * 2; return st * 1024 + (ob ^ (((ob >> 9) & 1) << 5)); }
__host__ __device__ __forceinline__ void stage_rc(int b, int& R, int& C) { const int st = b / 1024, sb = b % 1024, swz = sb ^ (((sb >> 9) & 1) << 5); R = (st >> 1) * 16 + swz / 64; C = (st & 1) * 32 + (swz % 64) / 2; }
__host__ __device__ __forceinline__ int perm32(int rho) { const int n = rho >> 4, i = rho & 15; return 8 * (i >> 2) + 4 * n + (i & 3); }

struct Unit { int pm, pn; };
struct Gemm { const bf16_t* A; const bf16_t* Bt; int M, N, K; };

struct StaticOrder {
    int nM, nN, nwg, G, c;
    __host__ __device__ void init(int M, int N, int G_, int c_) { nM = M / BM; nN = N / BM; nwg = nM * nN; G = G_; c = c_; }
    __host__ __device__ bool next(int i, Unit& u) const {
        const long L = (long)i * G + c; if (L >= nwg) return false;
        int wgid = (int)L; { const int q = nwg / NXCD, r = nwg % NXCD, xcd = wgid % NXCD, off = wgid / NXCD; wgid = (xcd < r ? xcd * (q + 1) : r * (q + 1) + (xcd - r) * q) + off; }
        const int nig = WGM * nN, gid = wgid / nig, fm = gid * WGM, gsz = (nM - fm) < WGM ? (nM - fm) : WGM;
        u.pm = fm + ((wgid % nig) % gsz); u.pn = (wgid % nig) / gsz; return true;
    }
    __device__ __forceinline__ void a_ready(const Unit&) const {}
    __device__ __forceinline__ void done(const Unit&) const {}
};

__device__ __forceinline__ unsigned cvt_pk_bf16(float lo, float hi) { unsigned r; asm volatile("v_cvt_pk_bf16_f32 %0, %1, %2" : "=v"(r) : "v"(lo), "v"(hi)); return r; }
typedef float f32x2 __attribute__((ext_vector_type(2)));
template <class Epi, class Sched, bool ALIGN_EPI = false, bool SP2 = false>
__device__ __forceinline__ void gemm_phase(PG8_LAS unsigned char* lds, const Gemm g, const Sched& S, const Epi& E) {
    const int tid = TID(), wid = __builtin_amdgcn_readfirstlane(tid >> 6), lane = tid & 63, wr = wid >> 2, wc = wid & 3, fr = lane & 15, fq = lane >> 4;
    const int K = g.K, nt = K / BK;
    unsigned voffA[2], voffB[2];
#pragma unroll
    for (int i = 0; i < 2; ++i) { int R, C; stage_rc(tid * 16 + i * 8192, R, C); const int Rb = Epi::PERM ? ((R & ~31) + perm32(R & 31)) : R;
        voffA[i] = (unsigned)(R * K + C) * 2u; voffB[i] = (unsigned)(Rb * K + C) * 2u; }
    const size_t kstep = (size_t)(BK * 2);
    const size_t hstep = (size_t)HALF * K * 2;
    const size_t tstep = 2 * hstep;
    const unsigned ldsw = (unsigned)wid * 1024u;
    const int aoff = lds_byte(wr * 64 + fr, fq * 8), boff = lds_byte(wc * 32 + fr, fq * 8);
#define PG8_SA(b, h) (((b) * 2 + (h)) * HTB)
#define PG8_SB(b, h) ((4 + (b) * 2 + (h)) * HTB)
#define PG8_STAGE(bufoff, gbase, voff) do { _Pragma("unroll") for (int _i = 0; _i < 2; ++_i) \
        __builtin_amdgcn_global_load_lds((const unsigned*)((const char*)(gbase) + (voff)[_i]), (PG8_LAS unsigned*)(lds + (bufoff) + ldsw + _i * 8192), 16, 0, 0); } while (0)
#define PG8_LDA(dst, b, h) do { _Pragma("unroll") for (int m = 0; m < 4; ++m) _Pragma("unroll") for (int k = 0; k < 2; ++k) dst[m][k] = *(const PG8_LAS bf16x8*)(lds + PG8_SA(b, h) + aoff + m * 2048 + k * 1024); } while (0)
#define PG8_LDB(dst, b, h) do { _Pragma("unroll") for (int n = 0; n < 2; ++n) _Pragma("unroll") for (int k = 0; k < 2; ++k) dst[n][k] = *(const PG8_LAS bf16x8*)(lds + PG8_SB(b, h) + boff + n * 2048 + k * 1024); } while (0)
#define PG8_MMA(ai, bj, At, Bt) do { __builtin_amdgcn_s_setprio(1); _Pragma("unroll") for (int m = 0; m < 4; ++m) _Pragma("unroll") for (int n = 0; n < 2; ++n) _Pragma("unroll") for (int k = 0; k < 2; ++k) \
        acc[ai][bj][m][n] = __builtin_amdgcn_mfma_f32_16x16x32_bf16(Bt[n][k], At[m][k], acc[ai][bj][m][n], 0, 0, 0); __builtin_amdgcn_s_setprio(0); } while (0)
#define PG8_WAIT_V(n) asm volatile("s_waitcnt vmcnt(" #n ")" ::: "memory")
#define PG8_WAIT_L(n) asm volatile("s_waitcnt lgkmcnt(" #n ")" ::: "memory")
#define PG8_BAR __builtin_amdgcn_s_barrier()
#define PG8_SCHED __builtin_amdgcn_sched_barrier(0)
    Unit cur, nxt; int ui = 0;
    if (!S.next(0, cur)) return;
    f32x4 acc[2][2][4][2];
#pragma unroll
    for (int a = 0; a < 2; ++a)
#pragma unroll
        for (int b = 0; b < 2; ++b)
#pragma unroll
            for (int m = 0; m < 4; ++m)
#pragma unroll
                for (int n = 0; n < 2; ++n) acc[a][b][m][n] = (f32x4){0.f, 0.f, 0.f, 0.f};
    bf16x8 At[4][2], B0[2][2], B1[2][2];
    const char* cA = (const char*)g.A + (size_t)cur.pm * tstep; const char* cB = (const char*)g.Bt + (size_t)cur.pn * tstep;
    S.a_ready(cur);
    if constexpr (SP2) {
        PG8_STAGE(PG8_SB(0, 0), cB, voffB); PG8_STAGE(PG8_SB(0, 1), cB + hstep, voffB); PG8_STAGE(PG8_SA(0, 0), cA, voffA); PG8_STAGE(PG8_SA(0, 1), cA + hstep, voffA);
        if (wr == 1) PG8_BAR;
        PG8_WAIT_V(2); PG8_BAR;
        PG8_STAGE(PG8_SB(1, 0), cB + kstep, voffB); PG8_STAGE(PG8_SA(1, 0), cA + kstep, voffA); PG8_STAGE(PG8_SB(1, 1), cB + hstep + kstep, voffB);
        PG8_WAIT_V(6); PG8_BAR;
    } else {
        PG8_STAGE(PG8_SB(0, 0), cB, voffB); PG8_STAGE(PG8_SA(0, 0), cA, voffA); PG8_STAGE(PG8_SB(0, 1), cB + hstep, voffB); PG8_STAGE(PG8_SA(0, 1), cA + hstep, voffA);
        if (wr == 1) PG8_BAR;
        PG8_WAIT_V(4); PG8_BAR;
        PG8_STAGE(PG8_SB(1, 0), cB + kstep, voffB); PG8_STAGE(PG8_SA(1, 0), cA + kstep, voffA); PG8_STAGE(PG8_SB(1, 1), cB + hstep + kstep, voffB);
        PG8_WAIT_V(6); PG8_BAR;
    }
    for (;;) {
        const bool has_next = S.next(ui + 1, nxt);
        const char* nA = has_next ? (const char*)g.A + (size_t)nxt.pm * tstep : cA; const char* nB = has_next ? (const char*)g.Bt + (size_t)nxt.pn * tstep : cB;
        for (int t = 0; t < nt; t += 2) {
            const bool last = (t == nt - 2);
            const char* a1 = cA + (size_t)(t + 1) * kstep;
            const char* a2 = last ? nA : cA + (size_t)(t + 2) * kstep; const char* b2 = last ? nB : cB + (size_t)(t + 2) * kstep;
            const char* a3 = a2 + kstep; const char* b3 = b2 + kstep;
            if (last && has_next) S.a_ready(nxt);
            if constexpr (SP2) {
            PG8_LDB(B0, 0, 0); PG8_LDB(B1, 0, 1); PG8_SCHED; PG8_LDA(At, 0, 0); PG8_STAGE(PG8_SA(1, 1), a1 + hstep, voffA);
            PG8_WAIT_V(8); PG8_WAIT_L(0); PG8_BAR; PG8_MMA(0, 0, At, B0); PG8_MMA(0, 1, At, B1); PG8_BAR; PG8_SCHED;
            PG8_LDA(At, 0, 1); PG8_STAGE(PG8_SB(0, 0), b2, voffB); PG8_STAGE(PG8_SB(0, 1), b2 + hstep, voffB); PG8_STAGE(PG8_SA(0, 0), a2, voffA);
            PG8_WAIT_V(8); PG8_WAIT_L(0); PG8_BAR; PG8_MMA(1, 0, At, B0); PG8_MMA(1, 1, At, B1); PG8_BAR; PG8_SCHED;
            PG8_LDB(B0, 1, 0); PG8_LDB(B1, 1, 1); PG8_SCHED; PG8_LDA(At, 1, 0); PG8_STAGE(PG8_SA(0, 1), a2 + hstep, voffA);
            PG8_WAIT_V(8); PG8_WAIT_L(0); PG8_BAR; PG8_MMA(0, 0, At, B0); PG8_MMA(0, 1, At, B1); PG8_BAR; PG8_SCHED;
            PG8_LDA(At, 1, 1); PG8_STAGE(PG8_SB(1, 0), b3, voffB); PG8_STAGE(PG8_SB(1, 1), b3 + hstep, voffB); PG8_STAGE(PG8_SA(1, 0), a3, voffA);
            PG8_WAIT_V(8); PG8_WAIT_L(0); PG8_BAR; PG8_MMA(1, 0, At, B0); PG8_MMA(1, 1, At, B1); PG8_BAR; PG8_SCHED;
            } else {
            PG8_LDB(B0, 0, 0); PG8_SCHED; PG8_LDA(At, 0, 0); PG8_STAGE(PG8_SA(1, 1), a1 + hstep, voffA);
            PG8_WAIT_L(8); PG8_BAR; PG8_WAIT_L(0); PG8_MMA(0, 0, At, B0); PG8_BAR; PG8_SCHED;
            PG8_LDB(B1, 0, 1); PG8_STAGE(PG8_SB(0, 0), b2, voffB);
            PG8_BAR; PG8_WAIT_L(0); PG8_MMA(0, 1, At, B1); PG8_BAR;
            PG8_LDA(At, 0, 1); PG8_STAGE(PG8_SA(0, 0), a2, voffA);
            PG8_BAR; PG8_WAIT_L(0); PG8_MMA(1, 0, At, B0); PG8_BAR; PG8_SCHED;
            PG8_STAGE(PG8_SB(0, 1), b2 + hstep, voffB);
            PG8_WAIT_V(6); PG8_BAR; PG8_MMA(1, 1, At, B1); PG8_BAR;
            PG8_LDB(B0, 1, 0); PG8_SCHED; PG8_LDA(At, 1, 0); PG8_STAGE(PG8_SA(0, 1), a2 + hstep, voffA);
            PG8_WAIT_L(8); PG8_BAR; PG8_WAIT_L(0); PG8_MMA(0, 0, At, B0); PG8_BAR; PG8_SCHED;
            PG8_LDB(B1, 1, 1); PG8_STAGE(PG8_SB(1, 0), b3, voffB);
            PG8_BAR; PG8_WAIT_L(0); PG8_MMA(0, 1, At, B1); PG8_BAR;
            PG8_LDA(At, 1, 1); PG8_STAGE(PG8_SA(1, 0), a3, voffA);
            PG8_BAR; PG8_WAIT_L(0); PG8_MMA(1, 0, At, B0); PG8_BAR; PG8_SCHED;
            PG8_STAGE(PG8_SB(1, 1), b3 + hstep, voffB);
            PG8_WAIT_V(6); PG8_BAR; PG8_MMA(1, 1, At, B1); PG8_BAR;
            }
        }
        if constexpr (ALIGN_EPI) { if (wr == 0) PG8_BAR; }
        if constexpr (!Epi::AFTER_DRAIN) { E(acc, cur, wr, wc, fr, fq); S.done(cur); }
        if (!has_next) break;
#pragma unroll
        for (int a = 0; a < 2; ++a)
#pragma unroll
            for (int b = 0; b < 2; ++b)
#pragma unroll
                for (int m = 0; m < 4; ++m)
#pragma unroll
                    for (int n = 0; n < 2; ++n) acc[a][b][m][n] = (f32x4){0.f, 0.f, 0.f, 0.f};
        cur = nxt; cA = nA; cB = nB; ++ui;
        if constexpr (ALIGN_EPI) { if (wr == 1) PG8_BAR; }
    }
    PG8_WAIT_V(0);
    if constexpr (!ALIGN_EPI) { if (wr == 0) PG8_BAR; }
    PG8_BAR;
    if constexpr (Epi::AFTER_DRAIN) { E.fused(acc, cur, wr, wc, fr, fq, lds, wid, lane); S.done(cur); }
#undef PG8_SA
#undef PG8_SB
#undef PG8_STAGE
#undef PG8_LDA
#undef PG8_LDB
#undef PG8_MMA
#undef PG8_WAIT_V
#undef PG8_WAIT_L
#undef PG8_BAR
#undef PG8_SCHED
}
}
#define LAS __attribute__((address_space(3)))
#define XB_TMO      128
#define XB_XCNT(j)  (256  + 64 * (j))
#define XB_XSUB(j)  (1280 + 64 * (j))
#define XB_XGEN(j)  (2304 + 64 * (j))
#define XB_TOP      3328
#define XB_TOPGEN   3392
#define XCD_BAR_WORDS 3456
#define XB_SPIN_CAP (1u << 18)

__device__ __forceinline__ unsigned xb_ld(unsigned* p)              { return __hip_atomic_load(p, __ATOMIC_RELAXED, __HIP_MEMORY_SCOPE_AGENT); }
__device__ __forceinline__ unsigned xb_add(unsigned* p, unsigned v) { return __hip_atomic_fetch_add(p, v, __ATOMIC_RELAXED, __HIP_MEMORY_SCOPE_AGENT); }
__device__ __forceinline__ unsigned xb_xcc_id() { return (unsigned)__builtin_amdgcn_s_getreg((3 << 11) | 20) & 0xFu; }
#define XB_SPIN(cond, bar) do { unsigned _sp = 0; while (cond) { __builtin_amdgcn_s_sleep(1); \
    if ((++_sp & 255u) == 0u) { if (xb_ld(&(bar)[XB_TMO])) break; if (_sp > XB_SPIN_CAP) { atomicAdd(&(bar)[XB_TMO], 1u); break; } } } } while (0)

struct XcdBarrier {
    unsigned* bar; unsigned x;
    volatile LAS unsigned* st;
};

__device__ __forceinline__ XcdBarrier xcd_barrier_post(unsigned* bar, volatile LAS unsigned* st) {
    XcdBarrier b; b.bar = bar; b.x = xb_xcc_id(); b.st = st;
    if (threadIdx.x == 0) (void)xb_add(&bar[XB_XCNT(b.x)], 1u);
    return b;
}
__device__ __forceinline__ void xcd_barrier_complete(unsigned* bar, unsigned x, unsigned& nloc, unsigned& nx) {
    const unsigned G = gridDim.x * gridDim.y * gridDim.z;
    unsigned sum, cnt, mine, sp = 0u;
    for (;;) {
        sum = 0u; cnt = 0u; mine = 0u;
#pragma unroll
        for (unsigned j = 0; j < 16; ++j) { const unsigned c = xb_ld(&bar[XB_XCNT(j)]); sum += c; cnt += (c > 0u) ? 1u : 0u; mine = (j == x) ? c : mine; }
        if (sum == G) break;
        __builtin_amdgcn_s_sleep(1);
        if ((++sp & 255u) == 0u) { if (xb_ld(&bar[XB_TMO])) break; if (sp > XB_SPIN_CAP) { atomicAdd(&bar[XB_TMO], 1u); break; } }
    }
    nloc = mine > 0u ? mine : 1u; nx = cnt > 0u ? cnt : 1u;
}

__device__ __forceinline__ void xcd_barrier(const XcdBarrier& b) {
    asm volatile("s_waitcnt vmcnt(0)" ::: "memory");
    __syncthreads();
    if (threadIdx.x == 0) {
        unsigned* bar = b.bar;
        __builtin_amdgcn_s_waitcnt(0);
        unsigned nloc = b.st[0], nx = b.st[1];
        if (nloc == 0u) { xcd_barrier_complete(bar, b.x, nloc, nx); b.st[0] = nloc; b.st[1] = nx; }
        const unsigned old = xb_add(&bar[XB_XSUB(b.x)], 1u);
        const unsigned gen = old / nloc;
        if (old + 1u == (gen + 1u) * nloc) {
            __builtin_amdgcn_fence(__ATOMIC_RELEASE, "agent");
            asm volatile("s_waitcnt vmcnt(0)" ::: "memory");
            const unsigned og = xb_add(&bar[XB_TOP], 1u);
            const unsigned tg = og / nx;
            if (og + 1u == (tg + 1u) * nx) xb_add(&bar[XB_TOPGEN], 1u);
            else XB_SPIN(xb_ld(&bar[XB_TOPGEN]) == tg, bar);
            __builtin_amdgcn_fence(__ATOMIC_ACQUIRE, "agent");
            xb_add(&bar[XB_XGEN(b.x)], 1u);
            asm volatile("s_waitcnt vmcnt(0)" ::: "memory");
        } else {
            XB_SPIN(xb_ld(&bar[XB_XGEN(b.x)]) == gen, bar);
            __builtin_amdgcn_fence(__ATOMIC_ACQUIRE, "agent");
            asm volatile("s_waitcnt vmcnt(0)" ::: "memory");
        }
    }
    __syncthreads();
}
#ifndef PROBE
#define PROBE 0
#endif

using pg8::bf16_t; using pg8::bf16x8; using pg8::f32x4; using pg8::u32x4; using pg8::cvt_pk_bf16;

typedef unsigned u32x2 __attribute__((ext_vector_type(2)));
typedef float f32x2v __attribute__((ext_vector_type(2)));

constexpr int T = 32768, D = 1024, DFF = 2816, SEQ = 16384;
constexpr int LDS_BYTES = 151552;
constexpr float EPS = 1e-6f;
constexpr size_t MiB = 1ull << 20;
constexpr size_t OFF_W = 0;
constexpr size_t OFF_R1 = 52 * MiB;
constexpr size_t OFF_YH = OFF_R1 + 192 * MiB;
constexpr size_t OFF_MOD = OFF_YH + 64 * MiB;
constexpr size_t OFF_PART = OFF_MOD + 256 * 1024;
constexpr size_t OFF_BAR = OFF_PART + 6 * MiB;
constexpr size_t OFF_R2 = OFF_BAR + 16384;
constexpr int LDV = T + 64;
constexpr size_t WS_END = OFF_R2 + 193 * MiB;
constexpr size_t W_IN0 = 0, W_IN1 = (size_t)2 * DFF * D, W_OUT0 = (size_t)4 * DFF * D, W_OUT1 = W_OUT0 + (size_t)D * DFF, W_X = W_OUT1 + (size_t)D * DFF;
constexpr size_t W_HGOUT = W_X + (size_t)4096 * D, W_GMOUT = W_X + (size_t)6144 * D;

struct Params {
    const float* in[19];
    float* out; unsigned char* ws;
    int ph_lo, ph_hi;
};
#define CAS __attribute__((address_space(4)))
__device__ __forceinline__ const CAS Params* KP() { const CAS Params* q = (const CAS Params*)__builtin_amdgcn_kernarg_segment_ptr(); asm volatile("" : "+s"(q)); return q; }

__device__ __forceinline__ float frcp(float x) { return __builtin_amdgcn_rcpf(x); }
__device__ __forceinline__ float fexp(float x) { return __builtin_amdgcn_exp2f(x * 1.4426950408889634f); }
__device__ __forceinline__ float flog(float x) { return __builtin_amdgcn_logf(x) * 0.6931471805599453f; }
__device__ __forceinline__ float silu_f(float x) { return x * frcp(1.f + fexp(-x)); }
__device__ __forceinline__ float gelu_f(float x) { const float u = 1.5957691216f * (x + 0.044715f * x * x * x); return x * frcp(1.f + fexp(-u)); }
__device__ __forceinline__ f32x4 sigmoid4(const f32x4 x) {
    f32x4 r;
#pragma unroll
    for (int j = 0; j < 4; ++j) r[j] = __builtin_amdgcn_rcpf(1.f + __builtin_amdgcn_exp2f(x[j] * -1.4426950408889634f));
    return r;
}
__device__ __forceinline__ f32x4 silu4(const f32x4 x) { return x * sigmoid4(x); }
__device__ __forceinline__ f32x4 gelu4(const f32x4 x) { const f32x4 u = (x + x * x * x * 0.044715f) * 1.5957691216f; return x * sigmoid4(u); }
typedef _Float16 f16x2 __attribute__((ext_vector_type(2)));
__device__ __forceinline__ unsigned pk_h2(float a, float b) { f16x2 v; v.x = (_Float16)a; v.y = (_Float16)b; return __builtin_bit_cast(unsigned, v); }
__device__ __forceinline__ float h_lo(unsigned w) { return (float)__builtin_bit_cast(f16x2, w).x; }
__device__ __forceinline__ float h_hi(unsigned w) { return (float)__builtin_bit_cast(f16x2, w).y; }
__device__ __forceinline__ float bf_lo(unsigned w) { return __uint_as_float(w << 16); }
__device__ __forceinline__ float bf_hi(unsigned w) { return __uint_as_float(w & 0xffff0000u); }
__device__ __forceinline__ float bf1(unsigned short h) { return __uint_as_float(((unsigned)h) << 16); }
__device__ __forceinline__ u32x4 pack8(const f32x4 a, const f32x4 b) { u32x4 w; w.x = cvt_pk_bf16(a[0], a[1]); w.y = cvt_pk_bf16(a[2], a[3]); w.z = cvt_pk_bf16(b[0], b[1]); w.w = cvt_pk_bf16(b[2], b[3]); return w; }
#define DPP_ADD(v_, ctrl_, rm_) v_ += __builtin_bit_cast(float, __builtin_amdgcn_update_dpp(0, __builtin_bit_cast(int, v_), ctrl_, rm_, 0xF, false))
__device__ __forceinline__ float wave_sum(float v) {
    DPP_ADD(v, 0xB1, 0xF);
    DPP_ADD(v, 0x4E, 0xF);
    DPP_ADD(v, 0x141, 0xF);
    DPP_ADD(v, 0x140, 0xF);
    DPP_ADD(v, 0x142, 0xA);
    DPP_ADD(v, 0x143, 0xC);
    return __builtin_bit_cast(float, __builtin_amdgcn_readlane(__builtin_bit_cast(int, v), 63));
}
#define LDS_WAIT() asm volatile("s_waitcnt lgkmcnt(0)" ::: "memory")
#define LDS_BARRIER() do { asm volatile("s_waitcnt lgkmcnt(0)" ::: "memory"); __builtin_amdgcn_s_barrier(); asm volatile("" ::: "memory"); } while (0)

struct Epi {
    static constexpr bool PERM = true, AFTER_DRAIN = false;
    int mode_in;
    __device__ __forceinline__ void operator()(const f32x4 (&acc)[2][2][4][2], const pg8::Unit& u_in, int wr, int wc, int fr, int fq) const {
        if (mode_in == 7) return;
        const CAS Params* kp = KP();
        unsigned char* ws = kp->ws;
        pg8::Unit u = u_in; const int mode = mode_in & 7;
        if (mode_in & 8) { u.pm = 0; u.pn = u_in.pn & 3; }
        const int row0 = u.pm * 256 + wr * 64 + fr;
        if (mode == 0) {
            bf16_t* o0 = (bf16_t*)(ws + OFF_YH); constexpr int ldc = D;
            const int col0 = u.pn * 256 + wc * 32 + 8 * fq;
#pragma unroll
            for (int ai = 0; ai < 2; ++ai)
#pragma unroll
                for (int m = 0; m < 4; ++m) { bf16_t* rowp = o0 + (size_t)(row0 + ai * 128 + m * 16) * ldc + col0;
#pragma unroll
                    for (int bj = 0; bj < 2; ++bj) __builtin_nontemporal_store(pack8(acc[ai][bj][m][0], acc[ai][bj][m][1]), (u32x4*)(rowp + bj * 128)); }
        } else if (mode == 1) {
            bf16_t* o0 = (bf16_t*)(ws + OFF_R1); constexpr int ldc = DFF;
            const int col0 = u.pn * 128 + wc * 32 + 8 * fq;
#pragma unroll
            for (int ai = 0; ai < 2; ++ai)
#pragma unroll
                for (int m = 0; m < 4; ++m) { bf16_t* rowp = o0 + (size_t)(row0 + ai * 128 + m * 16) * ldc + col0;
                    const f32x4 r0 = silu4(acc[ai][0][m][0]) * acc[ai][1][m][0], r1 = silu4(acc[ai][0][m][1]) * acc[ai][1][m][1];
                    __builtin_nontemporal_store(pack8(r0, r1), (u32x4*)rowp); }
        } else if (mode == 2) {
            bf16_t* o0 = (bf16_t*)(ws + OFF_R1); bf16_t* o1 = (bf16_t*)(ws + OFF_R1 + 64 * MiB); bf16_t* o2 = (bf16_t*)(ws + OFF_R1 + 128 * MiB); bf16_t* o3 = (bf16_t*)(ws + OFF_R2 + 128 * MiB);
            bf16_t* f0 = (bf16_t*)(ws + OFF_R2); const float* p0 = kp->in[11];
            const int sect = u.pn >> 2;
            const int col0 = (u.pn & 3) * 256 + wc * 32 + 8 * fq;
            if (sect == 1) {
#pragma unroll
                for (int bj = 0; bj < 2; ++bj) {
                    const int c = col0 + bj * 128;
                    f32x4 lbv[2], omv[2];
#pragma unroll
                    for (int n = 0; n < 2; ++n) {
                        const f32x4 a0 = *(const f32x4*)(p0 + c + 4 * n), a1 = *(const f32x4*)(p0 + 1024 + c + 4 * n), a2 = *(const f32x4*)(p0 + 2048 + c + 4 * n);
#pragma unroll
                        for (int j = 0; j < 4; ++j) { const float mx = fmaxf(a0[j], fmaxf(a1[j], a2[j])); const float e0 = fexp(a0[j] - mx), e1 = fexp(a1[j] - mx), e2 = fexp(a2[j] - mx);
                            const float lb = e0 / (e0 + e1 + e2); lbv[n][j] = lb; omv[n][j] = 1.f - lb; }
                    }
#pragma unroll
                    for (int ai = 0; ai < 2; ++ai)
#pragma unroll
                        for (int m = 0; m < 4; ++m) { const size_t off = (size_t)(row0 + ai * 128 + m * 16) * 1024 + c;
                            f32x4 l0, l1;
                            const f32x4 g0 = sigmoid4(acc[ai][bj][m][0]), g1 = sigmoid4(acc[ai][bj][m][1]);
#pragma unroll
                            for (int j = 0; j < 4; ++j) { l0[j] = flog(lbv[0][j] + omv[0][j] * g0[j]); l1[j] = flog(lbv[1][j] + omv[1][j] * g1[j]); }
                            { u32x4 lw; lw.x = pk_h2(l0[0], l0[1]); lw.y = pk_h2(l0[2], l0[3]); lw.z = pk_h2(l1[0], l1[1]); lw.w = pk_h2(l1[2], l1[3]); *(u32x4*)(f0 + off) = lw; }
                            }
                }
            } else {
                bf16_t* dst = sect == 0 ? o0 : (sect == 2 ? o2 : o3);
                const bool act = sect != 2;
#pragma unroll
                for (int ai = 0; ai < 2; ++ai)
#pragma unroll
                    for (int m = 0; m < 4; ++m) { bf16_t* rowp = dst + (size_t)(row0 + ai * 128 + m * 16) * 1024 + col0;
#pragma unroll
                        for (int bj = 0; bj < 2; ++bj) { f32x4 v0 = acc[ai][bj][m][0], v1 = acc[ai][bj][m][1];
                            if (act) { v0 = silu4(v0); v1 = silu4(v1); }
                            *(u32x4*)(rowp + bj * 128) = pack8(v0, v1); } }
            }
        } else if (mode == 3) {
            bf16_t* o0 = (bf16_t*)(ws + OFF_R1); constexpr int ldc = 3072; const float* p0 = kp->in[13];
            const int col0 = u.pn * 256 + wc * 32 + 8 * fq;
            f32x4 bv[2][2];
#pragma unroll
            for (int bj = 0; bj < 2; ++bj)
#pragma unroll
                for (int n = 0; n < 2; ++n) bv[bj][n] = *(const f32x4*)(p0 + col0 + bj * 128 + 4 * n);
            u32x4 qc[2], qn[2];
            qc[0] = *(const u32x4*)(o0 + (size_t)row0 * ldc + col0); qc[1] = *(const u32x4*)(o0 + (size_t)row0 * ldc + col0 + 128); qn[0] = qc[0]; qn[1] = qc[1];
#pragma unroll
            for (int ai = 0; ai < 2; ++ai)
#pragma unroll
                for (int m = 0; m < 4; ++m) { bf16_t* rowp = o0 + (size_t)(row0 + ai * 128 + m * 16) * ldc + col0;
                    if (ai * 4 + m < 7) { const int nx = ai * 4 + m + 1; const bf16_t* np = o0 + (size_t)(row0 + (nx >> 2) * 128 + (nx & 3) * 16) * ldc + col0; qn[0] = *(const u32x4*)np; qn[1] = *(const u32x4*)(np + 128); }
                    asm volatile("" : "+v"(qc[0]), "+v"(qc[1]));
#pragma unroll
                    for (int bj = 0; bj < 2; ++bj) { f32x4 v0 = acc[ai][bj][m][0] + bv[bj][0], v1 = acc[ai][bj][m][1] + bv[bj][1];
                        const u32x4 q = qc[bj];
                        v0 = gelu4(v0) * (f32x4){bf_lo(q.x), bf_hi(q.x), bf_lo(q.y), bf_hi(q.y)}; v1 = gelu4(v1) * (f32x4){bf_lo(q.z), bf_hi(q.z), bf_lo(q.w), bf_hi(q.w)};
                        *(u32x4*)(rowp + bj * 128) = pack8(v0, v1); }
                    qc[0] = qn[0]; qc[1] = qn[1]; }
        } else {
            bf16_t* o0 = (bf16_t*)(ws + OFF_R2); constexpr int ldc = LDV; const float* p0 = kp->in[13] + 3072; float* part = (float*)(ws + OFF_PART);
            const int col0 = u.pn * 256 + wc * 32 + 8 * fq;
            f32x4 s[2][2], q[2][2];
#pragma unroll
            for (int bj = 0; bj < 2; ++bj)
#pragma unroll
                for (int n = 0; n < 2; ++n) { s[bj][n] = (f32x4){0.f, 0.f, 0.f, 0.f}; q[bj][n] = (f32x4){0.f, 0.f, 0.f, 0.f}; }
            float bv8[8];
#pragma unroll
            for (int i8 = 0; i8 < 8; ++i8) bv8[i8] = p0[row0 + (i8 >> 2) * 128 + (i8 & 3) * 16];
#pragma unroll
            for (int ai = 0; ai < 2; ++ai)
#pragma unroll
                for (int m = 0; m < 4; ++m) { const int row = row0 + ai * 128 + m * 16; const float bv = bv8[ai * 4 + m]; bf16_t* rowp = o0 + ((size_t)(u.pn * 2) * 3072 + row) * 128 + wc * 32 + 8 * fq;
#pragma unroll
                    for (int bj = 0; bj < 2; ++bj) { f32x4 v0 = acc[ai][bj][m][0] + bv, v1 = acc[ai][bj][m][1] + bv;
                        v0 = gelu4(v0); v1 = gelu4(v1);
                        s[bj][0] += v0; s[bj][1] += v1; q[bj][0] += v0 * v0; q[bj][1] += v1 * v1;
                        *(u32x4*)(rowp + (size_t)bj * 3072 * 128) = pack8(v0, v1); } }
#pragma unroll
            for (int bj = 0; bj < 2; ++bj)
#pragma unroll
                for (int n = 0; n < 2; ++n)
#pragma unroll
                    for (int j = 0; j < 4; ++j) {
                        { float sv = s[bj][n][j], qv = q[bj][n][j];
                          DPP_ADD(sv, 0xB1, 0xF); DPP_ADD(qv, 0xB1, 0xF); DPP_ADD(sv, 0x4E, 0xF); DPP_ADD(qv, 0x4E, 0xF); DPP_ADD(sv, 0x141, 0xF); DPP_ADD(qv, 0x141, 0xF); DPP_ADD(sv, 0x140, 0xF); DPP_ADD(qv, 0x140, 0xF);
                          s[bj][n][j] = sv; q[bj][n][j] = qv; } }
            if (fr == 0) {
                float* pp = part + ((size_t)(u.pm * 2 + wr) * T + col0) * 2;
#pragma unroll
                for (int bj = 0; bj < 2; ++bj)
#pragma unroll
                    for (int n = 0; n < 2; ++n) {
                        *(f32x4*)(pp + (bj * 128 + 4 * n) * 2) = (f32x4){s[bj][n][0], q[bj][n][0], s[bj][n][1], q[bj][n][1]};
                        *(f32x4*)(pp + (bj * 128 + 4 * n) * 2 + 4) = (f32x4){s[bj][n][2], q[bj][n][2], s[bj][n][3], q[bj][n][3]}; }
            }
        }
        if (PROBE == 16) asm volatile("s_waitcnt vmcnt(0)" ::: "memory");
    }
};

__device__ __forceinline__ void tp_params(const CAS Params* kp, int L, bf16_t* Wb, int it, int lane, const float*& sp, int& N, bf16_t*& dp, int& K) {
    const int nA = 2816, nB = 1408, nC = L == 0 ? 2048 : 3072;
    int r = it; const float* src; bf16_t* dst; int swz = 0;
    if (r < nA) { src = kp->in[6] + (size_t)(L * 2 + 0) * D * 2 * DFF; K = D; N = 2 * DFF; dst = Wb + W_IN0; swz = 1; }
    else if ((r -= nA) < nA) { src = kp->in[6] + (size_t)(L * 2 + 1) * D * 2 * DFF; K = D; N = 2 * DFF; dst = Wb + W_IN1; swz = 1; }
    else if ((r -= nA) < nB) { src = kp->in[7] + (size_t)(L * 2 + 0) * DFF * D; K = DFF; N = D; dst = Wb + W_OUT0; }
    else if ((r -= nB) < nB) { src = kp->in[7] + (size_t)(L * 2 + 1) * DFF * D; K = DFF; N = D; dst = Wb + W_OUT1; }
    else if ((r -= nB) < nC) { src = L == 0 ? kp->in[8] : kp->in[12]; K = D; N = L == 0 ? 4096 : 6144; dst = Wb + W_X; }
    else { r -= nC; src = L == 0 ? kp->in[9] : kp->in[18]; K = L == 0 ? D : 3072; N = D; dst = L == 0 ? Wb + W_HGOUT : Wb + W_GMOUT; }
    const int nblk = N >> 5, kb = r / nblk, nb = r - kb * nblk;
    const int dstrow0 = nb * 32, k0 = kb * 64;
    const int srccol0 = swz ? (((dstrow0 & 128) ? DFF : 0) + (dstrow0 >> 8) * 128 + (dstrow0 & 127)) : dstrow0;
    sp = src + (size_t)(k0 + (lane >> 5)) * N + srccol0 + (lane & 31);
    dp = dst + (size_t)(dstrow0 + (lane >> 3)) * K + k0 + 8 * (lane & 7);
}
__device__ __forceinline__ void tp_finish(const float (&R)[32], bf16_t* dp, int K, LAS float* scr, int lane) {
#pragma unroll
    for (int i = 0; i < 32; ++i) scr[(2 * i + (lane >> 5)) * 33 + (lane & 31)] = R[i];
    LDS_WAIT(); asm volatile("" ::: "memory");
    const int c = lane & 7;
    float tv[4][8];
#pragma unroll
    for (int j = 0; j < 4; ++j) { const LAS float* s = scr + (8 * c) * 33 + (lane >> 3) + 8 * j;
#pragma unroll
        for (int e8 = 0; e8 < 8; ++e8) tv[j][e8] = s[e8 * 33]; }
#pragma unroll
    for (int j = 0; j < 4; ++j) {
        u32x4 o; o.x = cvt_pk_bf16(tv[j][0], tv[j][1]); o.y = cvt_pk_bf16(tv[j][2], tv[j][3]); o.z = cvt_pk_bf16(tv[j][4], tv[j][5]); o.w = cvt_pk_bf16(tv[j][6], tv[j][7]);
        *(u32x4*)(dp + (size_t)(8 * j) * K) = o; }
    LDS_WAIT(); asm volatile("" ::: "memory");
}
__device__ __forceinline__ void prep_weights(LAS unsigned char* lds, int L) {
    const CAS Params* kp = KP();
    const int lane = TID() & 63, wave = TID() >> 6;
    LAS float* scr = (LAS float*)(lds + wave * 8448);
    bf16_t* Wb = (bf16_t*)(kp->ws + OFF_W);
    const int gw = BID() * 8 + wave, NGW = gridDim.x * 8;
    const int total = 2 * 2816 + 2 * 1408 + (L == 0 ? 2048 + 512 : 3072 + 1536);
    for (int it = gw; it < total; it += 2 * NGW) {
        const bool hasB = it + NGW < total;
        const float *spA, *spB; bf16_t *dpA, *dpB; int NA, NB, KA, KB;
        tp_params(kp, L, Wb, it, lane, spA, NA, dpA, KA);
        tp_params(kp, L, Wb, hasB ? it + NGW : it, lane, spB, NB, dpB, KB);
        float RA[32], RB[32];
#pragma unroll
        for (int i = 0; i < 32; ++i) RA[i] = spA[(size_t)(2 * i) * NA];
#pragma unroll
        for (int i = 0; i < 32; ++i) RB[i] = hasB ? spB[(size_t)(2 * i) * NB] : 0.f;
        tp_finish(RA, dpA, KA, scr, lane);
        if (hasB) tp_finish(RB, dpB, KB, scr, lane);
    }
}
__device__ __forceinline__ void mod_gemv(LAS unsigned char* lds) {
    const CAS Params* kp = KP(); const float* cin = kp->in[1]; const float* adaw = kp->in[2]; const float* adab = kp->in[3];
    const int tid = TID(), lane = tid & 63, wave = tid >> 6;
    LAS float* cond = (LAS float*)(lds + 73728);
    LAS float* red = (LAS float*)(lds + 73728 + 8192);
    float* mod = (float*)(kp->ws + OFF_MOD);
    __syncthreads();
    for (int i = tid; i < 2048; i += 512) cond[i] = silu_f(cin[i]);
    __syncthreads();
    for (int it = BID(); it < 288; it += gridDim.x) {
        const int col = it * 64 + lane, l = col / 9216, n = col - l * 9216;
        const float* w = adaw + (size_t)l * D * 9216 + n;
        const int k0 = wave * 128;
        float a0 = 0.f, a1 = 0.f;
#pragma unroll 32
        for (int k = 0; k < 128; ++k) { const float wv = w[(size_t)(k0 + k) * 9216]; a0 += cond[k0 + k] * wv; a1 += cond[1024 + k0 + k] * wv; }
        red[(wave * 2 + 0) * 64 + lane] = a0; red[(wave * 2 + 1) * 64 + lane] = a1;
        __syncthreads();
        if (tid < 128) { const int b = tid >> 6, ln = tid & 63; float s = 0.f;
#pragma unroll
            for (int w8 = 0; w8 < 8; ++w8) s += red[(w8 * 2 + b) * 64 + ln];
            const int col2 = it * 64 + ln, l2 = col2 / 9216, n2 = col2 - l2 * 9216;
            mod[(size_t)(l2 * 2 + b) * 9216 + n2] = s + adab[l2 * 9216 + n2]; }
        __syncthreads();
    }
}

#ifndef XBF16
#define XBF16 1
#endif
__device__ __forceinline__ void norm_phase(int upd_l, int upd_s, int h_l, int h_s, int xsrc, int xdst, bool dummy, int vc) {
    const CAS Params* kp = KP(); unsigned char* ws = kp->ws; const float* npre = kp->in[4]; const float* npost = kp->in[5];
    const unsigned char* xin = xsrc == 0 ? (const unsigned char*)kp->in[0] : (xsrc == 1 || !XBF16) ? (const unsigned char*)kp->out : (const unsigned char*)(ws + OFF_R2);
    unsigned char* xout = dummy ? (ws + OFF_R2 + 64 * MiB) : ((xdst == 2 && XBF16) ? (ws + OFF_R2) : (unsigned char*)kp->out);
    const bool in_f32 = !XBF16 || xsrc == 0, out_f32 = !XBF16 || xdst == 3;
    const int lane = TID() & 63, wave = TID() >> 6;
#ifndef PROBE
#define PROBE 0
#endif
    const int bid_ = BID();
    if (PROBE == 15 && ((bid_ >> 3) & 1)) return;
    const int gw = (PROBE == 15 ? ((bid_ & 7) + 8 * (bid_ >> 4)) : bid_) * 8 + wave, NGW = (PROBE == 15 ? gridDim.x / 2 : gridDim.x) * 8;
    const float* mod = (const float*)(ws + OFF_MOD);
    const bf16_t* y = (const bf16_t*)(ws + OFF_YH);
    bf16_t* h = dummy ? (bf16_t*)(ws + OFF_R2 + 128 * MiB) : (bf16_t*)(ws + OFF_YH);
    const bool upd = upd_l >= 0, hh = h_l >= 0;
    const bool aff = gridDim.x == 256 && PROBE != 15;
    const int ax = vc & 7, aj = vc >> 3;
    for (int b = 0; b < 2; ++b) {
        if (aff && b != (ax >> 2)) continue;
        f32x4 A1[4], A2[4], A3[4];
#pragma unroll
        for (int j = 0; j < 4; ++j) { A1[j] = (f32x4){0.f, 0.f, 0.f, 0.f}; A2[j] = A1[j]; A3[j] = A1[j]; }
        if (upd) { const float rw = upd_s == 1 ? 1.0f : 0.5f;
            const f32x4* gate = (const f32x4*)(mod + ((size_t)(upd_l * 2 + b) * 9 + 3 * upd_s + 2) * D) + lane; const f32x4* post = (const f32x4*)(npost + (size_t)(upd_l * 3 + upd_s) * D) + lane;
#pragma unroll
            for (int j = 0; j < 4; ++j) A1[j] = gate[64 * j] * post[64 * j] * rw; }
        if (hh) { const f32x4* shift = (const f32x4*)(mod + ((size_t)(h_l * 2 + b) * 9 + 3 * h_s + 0) * D) + lane; const f32x4* scale = (const f32x4*)(mod + ((size_t)(h_l * 2 + b) * 9 + 3 * h_s + 1) * D) + lane;
            const f32x4* pre = (const f32x4*)(npre + (size_t)(h_l * 3 + h_s) * D) + lane;
#pragma unroll
            for (int j = 0; j < 4; ++j) { A2[j] = pre[64 * j] * (scale[64 * j] + 1.0f); A3[j] = shift[64 * j]; } }
        f32x4 v0[4], v1[4], v2[4], v3[4]; u32x2 xb0[4], xb1[4], xb2[4], xb3[4], yb0[4], yb1[4], yb2[4], yb3[4];
#define NP_LOAD(ROW_, V_, XB_, YB_) do { \
            if (in_f32) { const f32x4* xr_ = (const f32x4*)(xin + (size_t)(ROW_) * D * 4) + lane; _Pragma("unroll") for (int j = 0; j < 4; ++j) V_[j] = xr_[64 * j]; } \
            else { const u32x2* xr_ = (const u32x2*)(xin + (size_t)(ROW_) * D * 2) + lane; _Pragma("unroll") for (int j = 0; j < 4; ++j) XB_[j] = xr_[64 * j]; } \
            if (upd) { const u32x2* yr_ = (const u32x2*)(y + (size_t)(ROW_) * D) + lane; _Pragma("unroll") for (int j = 0; j < 4; ++j) YB_[j] = yr_[64 * j]; } } while (0)
#define NP_PROC(ROW_, V_, XB_, YB_) do { \
            if (!in_f32) { _Pragma("unroll") for (int j = 0; j < 4; ++j) V_[j] = (f32x4){h_lo(XB_[j].x), h_hi(XB_[j].x), h_lo(XB_[j].y), h_hi(XB_[j].y)}; } \
            if (upd) { \
                f32x4 yv[4]; float ss = 0.f; \
                _Pragma("unroll") for (int j = 0; j < 4; ++j) { const u32x2 w = YB_[j]; yv[j] = (f32x4){bf_lo(w.x), bf_hi(w.x), bf_lo(w.y), bf_hi(w.y)}; ss += (yv[j][0] * yv[j][0] + yv[j][1] * yv[j][1]) + (yv[j][2] * yv[j][2] + yv[j][3] * yv[j][3]); } \
                const float rstd = rsqrtf(wave_sum(ss) * (1.0f / D) + EPS); \
                _Pragma("unroll") for (int j = 0; j < 4; ++j) V_[j] += A1[j] * yv[j] * rstd; \
                if (out_f32) { f32x4* xo = (f32x4*)(xout + (size_t)(ROW_) * D * 4) + lane; _Pragma("unroll") for (int j = 0; j < 4; ++j) xo[64 * j] = V_[j]; } \
                else { u32x2* xo = (u32x2*)(xout + (size_t)(ROW_) * D * 2) + lane; _Pragma("unroll") for (int j = 0; j < 4; ++j) { u32x2 w; w.x = pk_h2(V_[j][0], V_[j][1]); w.y = pk_h2(V_[j][2], V_[j][3]); xo[64 * j] = w; } } \
            } \
            if (hh) { \
                float ss = 0.f; \
                _Pragma("unroll") for (int j = 0; j < 4; ++j) ss += (V_[j][0] * V_[j][0] + V_[j][1] * V_[j][1]) + (V_[j][2] * V_[j][2] + V_[j][3] * V_[j][3]); \
                const float rstd = rsqrtf(wave_sum(ss) * (1.0f / D) + EPS); \
                u32x2* ho = (u32x2*)(h + (size_t)(ROW_) * D) + lane; \
                _Pragma("unroll") for (int j = 0; j < 4; ++j) { const f32x4 o = V_[j] * rstd * A2[j] + A3[j]; u32x2 w; w.x = cvt_pk_bf16(o[0], o[1]); w.y = cvt_pk_bf16(o[2], o[3]); ho[64 * j] = w; } \
            } } while (0)
#pragma unroll
        for (int j = 0; j < 4; ++j) { v0[j] = (f32x4){0.f, 0.f, 0.f, 0.f}; v1[j] = v0[j]; v2[j] = v0[j]; v3[j] = v0[j]; xb0[j] = (u32x2){0u, 0u}; xb1[j] = xb0[j]; xb2[j] = xb0[j]; xb3[j] = xb0[j]; yb0[j] = xb0[j]; yb1[j] = xb0[j]; yb2[j] = xb0[j]; yb3[j] = xb0[j]; }
        const int rbeg = aff ? 4096 * ax + 128 * aj + 16 * wave : b * SEQ + gw, rend = aff ? rbeg + 16 : (b + 1) * SEQ, rstep = aff ? 1 : NGW;
        if (rbeg < rend) NP_LOAD(rbeg, v0, xb0, yb0);
        if (rbeg + rstep < rend) NP_LOAD(rbeg + rstep, v1, xb1, yb1);
        if (rbeg + 2 * rstep < rend) NP_LOAD(rbeg + 2 * rstep, v2, xb2, yb2);
        for (int row = rbeg; row < rend; row += 4 * rstep) {
            if (row + 3 * rstep < rend) NP_LOAD(row + 3 * rstep, v3, xb3, yb3);
            NP_PROC(row, v0, xb0, yb0);
            if (row + 4 * rstep < rend) NP_LOAD(row + 4 * rstep, v0, xb0, yb0);
            if (row + rstep < rend) NP_PROC(row + rstep, v1, xb1, yb1);
            if (row + 5 * rstep < rend) NP_LOAD(row + 5 * rstep, v1, xb1, yb1);
            if (row + 2 * rstep < rend) NP_PROC(row + 2 * rstep, v2, xb2, yb2);
            if (row + 6 * rstep < rend) NP_LOAD(row + 6 * rstep, v2, xb2, yb2);
            if (row + 3 * rstep < rend) NP_PROC(row + 3 * rstep, v3, xb3, yb3);
        }
#undef NP_PROC
#undef NP_LOAD
    }
}

#define MFMA16(a, b, c) __builtin_amdgcn_mfma_f32_16x16x32_bf16((a), (b), (c), 0, 0, 0)
__device__ __forceinline__ void hgrn_phase(LAS unsigned char* lds, const bool full, const int dmode = 0) {
    const bool dummy = dmode != 0;
    const CAS Params* kpar = KP(); unsigned char* ws = kpar->ws; const float* onorm = kpar->in[10];
    constexpr int QM = 0, KM = 17408, QI = 34816, STO = 52224, PP = 87040, VTO = 96256, KDT = 114688, SEG = 133120, BL = 137216, RED = 137728;
    const int tid = TID(), lane = tid & 63, wave = __builtin_amdgcn_readfirstlane(tid >> 6), fr = lane & 15, fq = lane >> 4;
    const int kp = tid & 63, sg = tid >> 6;
    const bf16_t* qs = (const bf16_t*)(ws + OFF_R1); const bf16_t* kkp = (const bf16_t*)(ws + OFF_R1 + 64 * MiB); const bf16_t* ivp = (const bf16_t*)(ws + OFF_R1 + 128 * MiB);
    const bf16_t* lfp = (const bf16_t*)(ws + OFF_R2);   const bf16_t* gsp = (const bf16_t*)(ws + OFF_R2 + 128 * MiB);
    bf16_t* og = (bf16_t*)(ws + OFF_R1);
    f32x4* Lbuf = (f32x4*)(ws + OFF_YH); float* logDbuf = (float*)(ws + OFF_YH + 16 * MiB);
    LAS float* segs = (LAS float*)(lds + SEG); LAS float* blv = (LAS float*)(lds + BL); LAS float* red = (LAS float*)(lds + RED);
    for (int item = BID(); item < 256; item += gridDim.x) {
        const int bh = item >> 4, sc = item & 15, b = bh >> 3, hd = bh & 7;
        const size_t tok0 = (size_t)b * SEQ + (size_t)sc * 1024;
        f32x4 S[8];
#pragma unroll
        for (int vt = 0; vt < 8; ++vt) S[vt] = (f32x4){0.f, 0.f, 0.f, 0.f};
        f32x2v logD2 = (f32x2v){0.f, 0.f};
        __syncthreads();
        if (full) {
            f32x4 suff = (f32x4){0.f, 0.f, 0.f, 0.f};
            f32x4 La[8], Lb[8], lda, ldb;
#define HG_LLOAD(I_, L_, LD_) do { const int pit_ = bh * 16 + (I_); LD_ = *(const f32x4*)(logDbuf + pit_ * 128 + 16 * wave + fq * 4); \
                _Pragma("unroll") for (int vt = 0; vt < 8; ++vt) L_[vt] = Lbuf[(size_t)(pit_ * 8 + vt) * 512 + tid]; } while (0)
#pragma unroll
            for (int vt = 0; vt < 8; ++vt) { La[vt] = (f32x4){0.f, 0.f, 0.f, 0.f}; Lb[vt] = La[vt]; }
            lda = La[0]; ldb = La[0];
            if (sc > 0) HG_LLOAD(sc - 1, La, lda);
            for (int i = sc - 1; i >= 0; --i) {
                if (i > 0) HG_LLOAD(i - 1, Lb, ldb);
                asm volatile("" : "+v"(La[0]), "+v"(La[1]), "+v"(La[2]), "+v"(La[3]), "+v"(La[4]), "+v"(La[5]), "+v"(La[6]), "+v"(La[7]), "+v"(lda));
                const f32x4 pk = (f32x4){fexp(suff[0]), fexp(suff[1]), fexp(suff[2]), fexp(suff[3])};
#pragma unroll
                for (int vt = 0; vt < 8; ++vt) { S[vt] += La[vt] * pk; La[vt] = Lb[vt]; }
                suff += lda; lda = ldb; }
#undef HG_LLOAD
#pragma unroll
            for (int vt = 0; vt < 8; ++vt) { u32x2 w; w.x = cvt_pk_bf16(S[vt][0], S[vt][1]); w.y = cvt_pk_bf16(S[vt][2], S[vt][3]);
                *(LAS u32x2*)(lds + STO + (16 * vt + fr) * 272 + (16 * wave + fq * 4) * 2) = w; }
        }
        f32x2v lf2[8]; unsigned v2[8], q2[8];
#define HG_LOAD(CI) do { const size_t gb_ = (tok0 + (size_t)(CI) * 64 + sg * 8) * 1024 + hd * 128 + 2 * kp; \
            _Pragma("unroll") for (int i = 0; i < 8; ++i) { { const unsigned lw_ = *(const unsigned*)(lfp + gb_ + (size_t)i * 1024); lf2[i] = (f32x2v){h_lo(lw_), h_hi(lw_)}; } v2[i] = *(const unsigned*)(ivp + gb_ + (size_t)i * 1024); \
                q2[i] = full ? *(const unsigned*)(qs + gb_ + (size_t)i * 1024) : 0u; } } while (0)
        f32x4 onv[4];
#pragma unroll
        for (int j = 0; j < 4; ++j) onv[j] = *(const f32x4*)(onorm + 16 * ((wave >> 2) * 4 + j) + fq * 4);
        HG_LOAD(0);
        for (int ci = 0; ci < 16; ++ci) {
            const size_t t0 = tok0 + (size_t)ci * 64;
            f32x2v run = (f32x2v){0.f, 0.f}, kraw[8];
#pragma unroll
            for (int i = 0; i < 8; ++i) { kraw[i] = (f32x2v){1.f - fexp(lf2[i].x), 1.f - fexp(lf2[i].y)}; run += lf2[i]; lf2[i] = run; }
            *(LAS f32x2v*)(segs + sg * 128 + 2 * kp) = run;
            LDS_BARRIER();
            f32x2v prefix = (f32x2v){0.f, 0.f}, bmid = prefix, blast = prefix;
#pragma unroll
            for (int s_ = 0; s_ < 8; ++s_) { const f32x2v sv = *(const LAS f32x2v*)(segs + s_ * 128 + 2 * kp); if (s_ < sg) prefix += sv; if (s_ < 4) bmid += sv; blast += sv; }
            if (sg == 0) { *(LAS f32x2v*)(blv + 2 * kp) = blast; logD2 += blast; }
            if (dmode != 3) {
                unsigned kda[4], kdb[4], vta[4], vtb[4];
#pragma unroll
                for (int i = 0; i < 8; i += 2) {
                    const f32x2v bb0 = prefix + lf2[i], bb1 = prefix + lf2[i + 1];
                    const float ka0 = kraw[i].x, kb0 = kraw[i].y, ka1 = kraw[i + 1].x, kb1 = kraw[i + 1].y;
                    kda[i >> 1] = cvt_pk_bf16(ka0 * fexp(blast.x - bb0.x), ka1 * fexp(blast.x - bb1.x));
                    kdb[i >> 1] = cvt_pk_bf16(kb0 * fexp(blast.y - bb0.y), kb1 * fexp(blast.y - bb1.y));
                    vta[i >> 1] = (v2[i] & 0xffffu) | (v2[i + 1] << 16);
                    vtb[i >> 1] = (v2[i] >> 16) | (v2[i + 1] & 0xffff0000u);
                    if (full) {
                        const int ta = sg * 8 + i;
                        { const float qa = bf_lo(q2[i]), qb = bf_hi(q2[i]);
                          *(LAS unsigned*)(lds + QM + ta * 272 + kp * 4) = cvt_pk_bf16(qa * fexp(bb0.x - bmid.x), qb * fexp(bb0.y - bmid.y));
                          *(LAS unsigned*)(lds + KM + ta * 272 + kp * 4) = cvt_pk_bf16(ka0 * fexp(bmid.x - bb0.x), kb0 * fexp(bmid.y - bb0.y));
                          *(LAS unsigned*)(lds + QI + ta * 272 + kp * 4) = cvt_pk_bf16(qa * fexp(bb0.x), qb * fexp(bb0.y)); }
                        { const float qa = bf_lo(q2[i + 1]), qb = bf_hi(q2[i + 1]);
                          *(LAS unsigned*)(lds + QM + (ta + 1) * 272 + kp * 4) = cvt_pk_bf16(qa * fexp(bb1.x - bmid.x), qb * fexp(bb1.y - bmid.y));
                          *(LAS unsigned*)(lds + KM + (ta + 1) * 272 + kp * 4) = cvt_pk_bf16(ka1 * fexp(bmid.x - bb1.x), kb1 * fexp(bmid.y - bb1.y));
                          *(LAS unsigned*)(lds + QI + (ta + 1) * 272 + kp * 4) = cvt_pk_bf16(qa * fexp(bb1.x), qb * fexp(bb1.y)); }
                    }
                }
                *(LAS u32x4*)(lds + KDT + (2 * kp) * 144 + sg * 16) = (u32x4){kda[0], kda[1], kda[2], kda[3]}; *(LAS u32x4*)(lds + KDT + (2 * kp + 1) * 144 + sg * 16) = (u32x4){kdb[0], kdb[1], kdb[2], kdb[3]};
                *(LAS u32x4*)(lds + VTO + (2 * kp) * 144 + sg * 16) = (u32x4){vta[0], vta[1], vta[2], vta[3]}; *(LAS u32x4*)(lds + VTO + (2 * kp + 1) * 144 + sg * 16) = (u32x4){vtb[0], vtb[1], vtb[2], vtb[3]};
            }
            LDS_BARRIER();
            if (ci + 1 < 16) HG_LOAD(ci + 1);
            if (dmode == 2) continue;
            f32x4 O[4];
            const int tt = wave & 3, vh = wave >> 2;
            const size_t orow = (t0 + 16 * tt + fr) * 1024 + hd * 128;
            u32x2 g2[4];
#pragma unroll
            for (int j = 0; j < 4; ++j) g2[j] = full ? *(const u32x2*)(gsp + orow + 16 * (vh * 4 + j) + fq * 4) : (u32x2){0u, 0u};
#define FRAG(BASE_, ROW_, STRIDE_, KS_) (*(const LAS bf16x8*)(lds + (BASE_) + (ROW_) * (STRIDE_) + ((KS_) * 32 + fq * 8) * 2))
#define PIN5(a_, b_, c_, d_, e_) asm volatile("" : "+v"(a_), "+v"(b_), "+v"(c_), "+v"(d_), "+v"(e_))
#define PIN4(a_, b_, c_, d_) asm volatile("" : "+v"(a_), "+v"(b_), "+v"(c_), "+v"(d_))
            if (full) {
                { const int ta = wave >> 1, st0 = (wave & 1) * 2;
                  bf16x8 yq[4], xk0[4], xk1[4];
#pragma unroll
                  for (int ks = 0; ks < 4; ++ks) { yq[ks] = FRAG(QM, 16 * ta + fr, 272, ks); xk0[ks] = FRAG(KM, 16 * st0 + fr, 272, ks); xk1[ks] = FRAG(KM, 16 * (st0 + 1) + fr, 272, ks); }
                  PIN4(yq[0], yq[1], yq[2], yq[3]); PIN4(xk0[0], xk0[1], xk0[2], xk0[3]); PIN4(xk1[0], xk1[1], xk1[2], xk1[3]);
#pragma unroll
                  for (int e = 0; e < 2; ++e) { const int st = st0 + e;
                    f32x4 a = (f32x4){0.f, 0.f, 0.f, 0.f};
                    if (st <= ta) {
#pragma unroll
                        for (int ks = 0; ks < 4; ++ks) a = MFMA16(e ? xk1[ks] : xk0[ks], yq[ks], a);
                        const int tg = 16 * ta + fr, sgl = 16 * st + fq * 4;
#pragma unroll
                        for (int r = 0; r < 4; ++r) a[r] = (sgl + r <= tg) ? a[r] : 0.f;
                    }
                    u32x2 w; w.x = cvt_pk_bf16(a[0], a[1]); w.y = cvt_pk_bf16(a[2], a[3]);
                    *(LAS u32x2*)(lds + PP + (16 * ta + fr) * 144 + (16 * st + fq * 4) * 2) = w; } }
#pragma unroll
                for (int j = 0; j < 4; ++j) O[j] = (f32x4){0.f, 0.f, 0.f, 0.f};
                { bf16x8 fy[2], fx[2][4];
                  fy[0] = FRAG(QI, 16 * tt + fr, 272, 0);
#pragma unroll
                  for (int j = 0; j < 4; ++j) fx[0][j] = FRAG(STO, 16 * (vh * 4 + j) + fr, 272, 0);
#pragma unroll
                  for (int ks = 0; ks < 4; ++ks) { const int cb = ks & 1, nb = cb ^ 1;
                    if (ks < 3) { fy[nb] = FRAG(QI, 16 * tt + fr, 272, ks + 1);
#pragma unroll
                        for (int j = 0; j < 4; ++j) fx[nb][j] = FRAG(STO, 16 * (vh * 4 + j) + fr, 272, ks + 1); }
                    PIN5(fy[cb], fx[cb][0], fx[cb][1], fx[cb][2], fx[cb][3]);
#pragma unroll
                    for (int j = 0; j < 4; ++j) O[j] = MFMA16(fx[cb][j], fy[cb], O[j]); } }
                LDS_BARRIER();
            }
            { bf16x8 xkd[2], yp[2], yb[2][4];
#pragma unroll
              for (int ks = 0; ks < 2; ++ks) { xkd[ks] = FRAG(KDT, 16 * wave + fr, 144, ks); yp[ks] = full ? FRAG(PP, 16 * tt + fr, 144, ks) : xkd[ks]; }
#pragma unroll
              for (int j = 0; j < 4; ++j) yb[0][j] = FRAG(VTO, 16 * j + fr, 144, 0);
              const f32x4 bl4 = *(const LAS f32x4*)(lds + BL + (16 * wave + fq * 4) * 4);
              const f32x4 dk = (f32x4){fexp(bl4[0]), fexp(bl4[1]), fexp(bl4[2]), fexp(bl4[3])};
#pragma unroll
              for (int vt = 0; vt < 8; ++vt) S[vt] = S[vt] * dk;
              PIN4(xkd[0], xkd[1], yp[0], yp[1]);
#pragma unroll
              for (int bi = 0; bi < 4; ++bi) { const int ks = bi >> 1, hf = bi & 1, cb = bi & 1, nb = cb ^ 1;
                  if (bi < 3) {
#pragma unroll
                      for (int j = 0; j < 4; ++j) yb[nb][j] = FRAG(VTO, 16 * (((bi + 1) & 1) * 4 + j) + fr, 144, (bi + 1) >> 1); }
                  PIN4(yb[cb][0], yb[cb][1], yb[cb][2], yb[cb][3]);
                  if (full && hf == vh) {
#pragma unroll
                      for (int j = 0; j < 4; ++j) O[j] = MFMA16(yb[cb][j], yp[ks], O[j]); }
#pragma unroll
                  for (int j = 0; j < 4; ++j) S[hf * 4 + j] = MFMA16(xkd[ks], yb[cb][j], S[hf * 4 + j]); } }
#undef FRAG
#undef PIN5
#undef PIN4
            if (full) {
#pragma unroll
                for (int vt = 0; vt < 8; ++vt) { u32x2 w; w.x = cvt_pk_bf16(S[vt][0], S[vt][1]); w.y = cvt_pk_bf16(S[vt][2], S[vt][3]);
                    *(LAS u32x2*)(lds + STO + (16 * vt + fr) * 272 + (16 * wave + fq * 4) * 2) = w; }
                float ssq = 0.f;
#pragma unroll
                for (int j = 0; j < 4; ++j) ssq += (O[j][0] * O[j][0] + O[j][1] * O[j][1]) + (O[j][2] * O[j][2] + O[j][3] * O[j][3]);
                ssq += __shfl_xor(ssq, 16); ssq += __shfl_xor(ssq, 32);
                if (fq == 0) red[vh * 64 + 16 * tt + fr] = ssq;
                LDS_BARRIER();
                const float rstd = rsqrtf((red[16 * tt + fr] + red[64 + 16 * tt + fr]) * (1.0f / 128.0f) + EPS);
#pragma unroll
                for (int j = 0; j < 4; ++j) { const int v0 = 16 * (vh * 4 + j) + fq * 4;
                    const f32x4 o = O[j] * rstd * onv[j] * (f32x4){bf_lo(g2[j].x), bf_hi(g2[j].x), bf_lo(g2[j].y), bf_hi(g2[j].y)};
                    u32x2 w; w.x = cvt_pk_bf16(o[0], o[1]); w.y = cvt_pk_bf16(o[2], o[3]);
                    if (!dummy) *(u32x2*)(og + orow + v0) = w; }
            }
        }
        if (!full) {
#pragma unroll
            for (int vt = 0; vt < 8; ++vt) Lbuf[(size_t)(item * 8 + vt) * 512 + tid] = S[vt];
            if (sg == 0) *(f32x2v*)(logDbuf + item * 128 + 2 * kp) = logD2;
        }
    }
}

__device__ __forceinline__ void spatial_phase(LAS unsigned char* lds, const int dmode = 0) {
    const bool dummy = dmode != 0;
    const CAS Params* kp = KP(); unsigned char* ws = kp->ws; const float* lng = kp->in[14]; const float* lnb = kp->in[15]; const float* wsp = kp->in[16]; const float* bsp = kp->in[17];
    constexpr int WM = 0, VN0 = 34816, VNH = 52224, MU = 139264;
    const int tid = TID(), lane = tid & 63, wave = __builtin_amdgcn_readfirstlane(tid >> 6), fr = lane & 15, fq = lane >> 4;
    bf16_t* u = (bf16_t*)(ws + OFF_R1); const bf16_t* vT = (const bf16_t*)(ws + OFF_R2); const f32x2v* part = (const f32x2v*)(ws + OFF_PART);
    const int c = BID(), G = (int)gridDim.x;
    const int g = c & 7, n0 = c >> 3, nstep = (G + 7 - g) >> 3;
    int nitems = n0 < 256 ? (256 - n0 + nstep - 1) / nstep : 0;
    if (nitems > 8) nitems = 8;
    if (nitems == 0) return;
    __syncthreads();
    for (int e = tid; e < nitems * 128; e += 512) { const int it = e >> 7, tk = e & 127; const size_t tok = (size_t)(n0 + it * nstep) * 128 + tk;
        float s_ = 0.f, q_ = 0.f;
#pragma unroll
        for (int pi = 0; pi < 24; ++pi) { const f32x2v v_ = part[(size_t)pi * T + tok]; s_ += v_.x; q_ += v_.y; }
        const float m_ = s_ * (1.0f / 3072.0f), var_ = q_ * (1.0f / 3072.0f) - m_ * m_;
        LAS float* mu_ = (LAS float*)(lds + MU + it * 1024); mu_[tk] = m_; mu_[128 + tk] = rsqrtf(var_ + EPS); }
    f32x4 wst[8];
#pragma unroll
    for (int i = 0; i < 8; ++i) { const int idx = tid + 512 * i, t = idx >> 5, s4 = (idx & 31) * 4; wst[i] = *(const f32x4*)(wsp + (size_t)(g * 128 + t) * 128 + s4); }
    asm volatile("" : "+v"(wst[0]), "+v"(wst[1]), "+v"(wst[2]), "+v"(wst[3]), "+v"(wst[4]), "+v"(wst[5]), "+v"(wst[6]), "+v"(wst[7]));
#pragma unroll
    for (int i = 0; i < 8; ++i) { const int idx = tid + 512 * i, t = idx >> 5, s4 = (idx & 31) * 4;
        const f32x4 w = wst[i];
        u32x2 o; o.x = cvt_pk_bf16(s4 + 0 <= t ? w[0] : 0.f, s4 + 1 <= t ? w[1] : 0.f); o.y = cvt_pk_bf16(s4 + 2 <= t ? w[2] : 0.f, s4 + 3 <= t ? w[3] : 0.f);
        *(LAS u32x2*)(lds + WM + t * 272 + s4 * 2) = o; }
    u32x4 rawA[6], rawB[6]; float lgA[6], lgB[6], lbA[6], lbB[6];
#define SP_LOAD(HI_, RAW_, LG_, LB_) do { const int n_ = n0 + ((HI_) >> 1) * nstep, h_ = (HI_) & 1; _Pragma("unroll") for (int i = 0; i < 6; ++i) { const int piece = tid + 512 * i, cl = piece >> 4, s8 = (piece & 15) * 8; const int ch = g * 384 + h_ * 192 + cl; \
        RAW_[i] = *(const u32x4*)(vT + ((size_t)n_ * 3072 + ch) * 128 + s8); LG_[i] = lng[ch]; LB_[i] = lnb[ch]; } } while (0)
    const int nst = 2 * nitems;
    SP_LOAD(0, rawA, lgA, lbA);
    SP_LOAD(1, rawB, lgB, lbB);
    const float bs = bsp[g * 128 + 16 * wave + fr];
    const int nks = (wave >> 1) + 1;
    __syncthreads();
#define SP_STAGE(HI_, RAW_, LG_, LB_) do { \
        const int it_ = (HI_) >> 1, half_ = (HI_) & 1, n_ = n0 + it_ * nstep; \
        if (dmode != 3) { const LAS float* mu = (const LAS float*)(lds + MU + it_ * 1024); const int s8 = (tid & 15) * 8;     \
          const f32x4 m0 = *(const LAS f32x4*)(mu + s8), m1 = *(const LAS f32x4*)(mu + s8 + 4), r0 = *(const LAS f32x4*)(mu + 128 + s8), r1 = *(const LAS f32x4*)(mu + 128 + s8 + 4); \
          _Pragma("unroll") for (int i = 0; i < 6; ++i) { const int piece = tid + 512 * i, cl = piece >> 4; \
            const int j = cl & 31, lrow = (cl & ~31) + ((j >> 2) & 1) * 16 + (j >> 3) * 4 + (j & 3); \
            f32x4 a = (f32x4){bf_lo(RAW_[i].x), bf_hi(RAW_[i].x), bf_lo(RAW_[i].y), bf_hi(RAW_[i].y)}, bq = (f32x4){bf_lo(RAW_[i].z), bf_hi(RAW_[i].z), bf_lo(RAW_[i].w), bf_hi(RAW_[i].w)}; \
            a = (a - m0) * r0 * LG_[i] + LB_[i]; bq = (bq - m1) * r1 * LG_[i] + LB_[i]; \
            *(LAS u32x4*)(lds + VN0 + half_ * VNH + lrow * 272 + s8 * 2) = pack8(a, bq); } } \
        LDS_BARRIER(); \
        if ((HI_) + 2 < nst) SP_LOAD((HI_) + 2, RAW_, LG_, LB_); \
        bf16_t* ub = u + ((size_t)n_ * 128 + 16 * wave + fr) * 3072 + g * 384 + half_ * 192 + fq * 8; \
        bf16x8 yf[4]; \
        _Pragma("unroll") for (int ks = 0; ks < 4; ++ks) yf[ks] = *(const LAS bf16x8*)(lds + WM + (16 * wave + fr) * 272 + (ks * 32 + fq * 8) * 2); \
        if (dmode != 2) { \
          bf16x8 xa[2][4], xb[2][4]; \
          _Pragma("unroll") for (int ks = 0; ks < 4; ++ks) { xa[0][ks] = yf[ks]; xb[0][ks] = yf[ks]; xa[1][ks] = yf[ks]; xb[1][ks] = yf[ks]; } \
          _Pragma("unroll") for (int ks = 0; ks < 4; ++ks) if (ks < nks) { xa[0][ks] = *(const LAS bf16x8*)(lds + VN0 + half_ * VNH + fr * 272 + (ks * 32 + fq * 8) * 2); xb[0][ks] = *(const LAS bf16x8*)(lds + VN0 + half_ * VNH + (16 + fr) * 272 + (ks * 32 + fq * 8) * 2); } \
          _Pragma("unroll") for (int p2 = 0; p2 < 6; ++p2) { const int cb = p2 & 1, nb = cb ^ 1; \
            if (p2 < 5) { _Pragma("unroll") for (int ks = 0; ks < 4; ++ks) if (ks < nks) { \
                xa[nb][ks] = *(const LAS bf16x8*)(lds + VN0 + half_ * VNH + (32 * (p2 + 1) + fr) * 272 + (ks * 32 + fq * 8) * 2); \
                xb[nb][ks] = *(const LAS bf16x8*)(lds + VN0 + half_ * VNH + (32 * (p2 + 1) + 16 + fr) * 272 + (ks * 32 + fq * 8) * 2); } } \
            asm volatile("" : "+v"(xa[cb][0]), "+v"(xa[cb][1]), "+v"(xa[cb][2]), "+v"(xa[cb][3])); asm volatile("" : "+v"(xb[cb][0]), "+v"(xb[cb][1]), "+v"(xb[cb][2]), "+v"(xb[cb][3])); \
            f32x4 a0 = (f32x4){0.f, 0.f, 0.f, 0.f}, a1 = a0; \
            _Pragma("unroll") for (int ks = 0; ks < 4; ++ks) if (ks < nks) { a0 = MFMA16(xa[cb][ks], yf[ks], a0); a1 = MFMA16(xb[cb][ks], yf[ks], a1); } \
            if (!dummy) *(u32x4*)(ub + 32 * p2) = pack8(a0 + bs, a1 + bs); } } \
    } while (0)
    for (int hi = 0; hi < nst; hi += 2) {
        SP_STAGE(hi, rawA, lgA, lbA);
        SP_STAGE(hi + 1, rawB, lgB, lbB);
    }
#undef SP_STAGE
#undef SP_LOAD
}

#ifndef GEMM_ALIGN
#define GEMM_ALIGN true
#endif
#ifndef GEMM_SP2
#define GEMM_SP2 true
#endif
enum { PT_PREP0 = 0, PT_NORM, PT_G1, PT_G2, PT_GPROJ, PT_H1, PT_H2, PT_GHOUT, PT_GV, PT_SPATIAL, PT_GU, PT_GMOUT };
constexpr int N_PHASES = 24;
__global__ void __launch_bounds__(512, 2) mega(Params p_unused) {
    extern __shared__ __attribute__((aligned(16))) unsigned char smem[];
    LAS unsigned char* lds = (LAS unsigned char*)smem;
    cg::grid_group grid = cg::this_grid();
    const int ph_lo = KP()->ph_lo, ph_hi = KP()->ph_hi;
    volatile LAS unsigned* xst = (volatile LAS unsigned*)(lds + LDS_BYTES - 16);
    if (threadIdx.x == 0) { xst[0] = 0u; xst[1] = 0u; xst[2] = blockIdx.x; xst[3] = 0u; }
    __syncthreads();
    XcdBarrier xb; xb.bar = (unsigned*)(KP()->ws + OFF_BAR); xb.x = xb_xcc_id(); xb.st = xst;
    if (ph_hi - ph_lo > 1) {
        xb = xcd_barrier_post((unsigned*)(KP()->ws + OFF_BAR), xst);
        if (threadIdx.x == 0) xst[3] = xb_add(&xb.bar[4 * xb.x], 1u);
    }
    for (int ph = ph_lo; ph < ph_hi; ++ph) {
        int type, a0 = 0, a1 = 0, a2 = -1, a3 = 0, a4 = 0;
        switch (ph) {
            case 0: type = PT_PREP0; break;
            case 1: type = PT_NORM; a0 = -1; a2 = 0; a3 = 0; break;
            case 2: type = PT_G1; a0 = 0; a1 = 0; break;
            case 3: type = PT_G2; a0 = 0; a1 = 0; break;
            case 4: type = PT_NORM; a0 = 0; a1 = 0; a2 = 0; a3 = 1; break;
            case 5: type = PT_GPROJ; break;
            case 6: type = PT_H1; break;
            case 7: type = PT_H2; break;
            case 8: type = PT_GHOUT; break;
            case 9: type = PT_NORM; a0 = 0; a1 = 1; a2 = 0; a3 = 2; break;
            case 10: type = PT_G1; a0 = 0; a1 = 1; break;
            case 11: type = PT_G2; a0 = 0; a1 = 1; break;
            case 12: type = PT_NORM; a0 = 0; a1 = 2; a2 = 1; a3 = 0; a4 = 1; break;
            case 13: type = PT_G1; a0 = 1; a1 = 0; break;
            case 14: type = PT_G2; a0 = 1; a1 = 0; break;
            case 15: type = PT_NORM; a0 = 1; a1 = 0; a2 = 1; a3 = 1; break;
            case 16: type = PT_GV; break;
            case 17: type = PT_SPATIAL; break;
            case 18: type = PT_GU; break;
            case 19: type = PT_GMOUT; break;
            case 20: type = PT_NORM; a0 = 1; a1 = 1; a2 = 1; a3 = 2; break;
            case 21: type = PT_G1; a0 = 1; a1 = 1; break;
            case 22: type = PT_G2; a0 = 1; a1 = 1; break;
            default: type = PT_NORM; a0 = 1; a1 = 2; a2 = -1; break;
        }
#ifndef EN
#define EN 0xff
#endif
#ifndef PROBE
#define PROBE 0
#endif
        for (int rep = 0; rep < (PROBE == 4 ? 2 : 1); ++rep) {
        if ((EN & 1) && (type == PT_PREP0 || (type == PT_NORM && a4))) prep_weights(lds, type == PT_PREP0 ? 0 : 1);
        if ((EN & 2) && type == PT_PREP0) mod_gemv(lds);
        }
        const int xsrc = ph <= 4 ? 0 : (ph == N_PHASES - 1 ? 2 : 1), xdst = ph == N_PHASES - 1 ? 3 : (ph == 20 ? 2 : 1);
        if (PROBE == 3 && type == PT_NORM) norm_phase(a0, a1, a2, a3, xsrc, xdst, true, __builtin_amdgcn_readfirstlane((int)xst[2]));
        if ((EN & 4) && type == PT_NORM) norm_phase(a0, a1, a2, a3, xsrc, xdst, false, __builtin_amdgcn_readfirstlane((int)xst[2]));
        for (int rep = 0; rep < (((PROBE == 2 && type == PT_H1) || ((PROBE == 5 || PROBE == 13 || PROBE == 14) && type == PT_H2)) ? 2 : 1); ++rep)
        if ((EN & 8) && (type == PT_H1 || type == PT_H2)) hgrn_phase(lds, type == PT_H2, (rep == 0 && type == PT_H2) ? (PROBE == 5 ? 1 : PROBE == 13 ? 2 : PROBE == 14 ? 3 : 0) : 0);
        for (int rep = 0; rep < ((PROBE == 6 || PROBE == 11 || PROBE == 12) ? 2 : 1); ++rep)
        if ((EN & 16) && type == PT_SPATIAL) spatial_phase(lds, rep == 0 ? (PROBE == 6 ? 1 : PROBE == 11 ? 2 : PROBE == 12 ? 3 : 0) : 0);
        if ((EN & 32) && (type == PT_G1 || type == PT_G2 || type == PT_GPROJ || type == PT_GHOUT || type == PT_GV || type == PT_GU || type == PT_GMOUT)) {
            const int ncall = 1;
            for (int cj = 0; cj < ncall * (((PROBE == 1 && type != PT_GU) || PROBE == 8 || PROBE == 10) ? 2 : 1); ++cj) { const int ci = cj % ncall;
                unsigned char* ws = KP()->ws;
                const bf16_t* Wb = (const bf16_t*)(ws + OFF_W);
                pg8::Gemm g; Epi E; E.mode_in = 0;
                g.A = (const bf16_t*)(ws + OFF_YH); g.M = T; g.N = D; g.K = D; g.Bt = Wb;
                if (type == PT_G1) { g.Bt = Wb + (a1 ? W_IN1 : W_IN0); g.N = 2 * DFF; g.K = D; E.mode_in = 1; }
                else if (type == PT_G2) { g.A = (const bf16_t*)(ws + OFF_R1); g.Bt = Wb + (a1 ? W_OUT1 : W_OUT0); g.N = D; g.K = DFF; }
                else if (type == PT_GPROJ) { g.Bt = Wb + W_X; g.N = 4096; g.K = D; E.mode_in = 2; }
                else if (type == PT_GHOUT) { g.A = (const bf16_t*)(ws + OFF_R1); g.Bt = Wb + W_HGOUT; g.N = D; g.K = D; }
                else if (type == PT_GMOUT) { g.A = (const bf16_t*)(ws + OFF_R1); g.Bt = Wb + W_GMOUT; g.N = D; g.K = 3072; }
                else if (type == PT_GU) { g.Bt = Wb + W_X; g.N = 3072; g.K = D; E.mode_in = 3; }
                else { g.A = Wb + W_X + (size_t)3072 * D; g.M = 3072; g.Bt = (const bf16_t*)(ws + OFF_YH); g.N = T; g.K = D; E.mode_in = 4; }
                if (PROBE == 8 && cj < ncall) E.mode_in = 7;
                if (PROBE == 10 && cj < ncall) E.mode_in |= 8;
                const int vcu = __builtin_amdgcn_readfirstlane((int)xst[2]);
                pg8::StaticOrder S; S.init(g.M, g.N, (int)gridDim.x, vcu);
                __syncthreads();
                pg8::gemm_phase<Epi, pg8::StaticOrder, GEMM_ALIGN, GEMM_SP2>(lds, g, S, E);
                __syncthreads();
            }
        }
        if (ph + 1 < ph_hi) {
            if (ph_hi > N_PHASES) grid.sync();
            xb.bar = (unsigned*)(KP()->ws + OFF_BAR); xcd_barrier(xb);
            if (PROBE == 7) { xcd_barrier(xb); xcd_barrier(xb); xcd_barrier(xb); }
            if (ph == ph_lo) {
                if (threadIdx.x == 0) { bool even = (gridDim.x & 7u) == 0u;
                    for (unsigned j = 0; j < 16; ++j) { const unsigned cnt = xb_ld(&xb.bar[XB_XCNT(j)]); even = even && (cnt == (j < 8 ? gridDim.x / 8u : 0u)); }
                    if (even && xb.x < 8u) xst[2] = xb.x + 8u * xst[3]; }
                __syncthreads();
            }
        }
    }
}

#ifndef MK_MULTI
#define MK_MULTI 0
#endif
extern "C" void kernel_launch(void* const* d_in, const int* in_sizes, int n_in, void* d_out, int out_size, void* d_ws, size_t ws_size, hipStream_t stream) {
    static int grid = 0;
    if (grid == 0) {
        if (n_in != 19 || in_sizes[0] != T * D || out_size != T * D || ws_size < WS_END) { fprintf(stderr, "kernel_launch: unexpected shapes / workspace: n_in %d in0 %d out %d ws %zu (need %zu)\n", n_in, n_in > 0 ? in_sizes[0] : -1, out_size, ws_size, (size_t)WS_END); grid = -1; return; }
        int dev = 0, cus = 0, per_cu = 0;
        if (hipGetDevice(&dev) != hipSuccess || hipDeviceGetAttribute(&cus, hipDeviceAttributeMultiprocessorCount, dev) != hipSuccess) { fprintf(stderr, "kernel_launch: device query failed\n"); grid = -1; return; }
        if (hipFuncSetAttribute((const void*)mega, hipFuncAttributeMaxDynamicSharedMemorySize, LDS_BYTES) != hipSuccess) { fprintf(stderr, "kernel_launch: hipFuncSetAttribute failed\n"); grid = -1; return; }
        if (hipOccupancyMaxActiveBlocksPerMultiprocessor(&per_cu, (const void*)mega, 512, LDS_BYTES) != hipSuccess || per_cu < 1) { fprintf(stderr, "kernel_launch: occupancy query says %d blocks per CU\n", per_cu); per_cu = 1; }
        (void)hipGetLastError();
        grid = cus;
    }
    if (grid < 0) return;
    if (hipMemsetAsync((unsigned char*)d_ws + OFF_BAR, 0, 16384, stream) != hipSuccess) { fprintf(stderr, "kernel_launch: hipMemsetAsync failed\n"); return; }
    Params p{};
    for (int i = 0; i < 19; ++i) p.in[i] = (const float*)d_in[i];
    p.out = (float*)d_out; p.ws = (unsigned char*)d_ws;
#if MK_MULTI
    for (int ph = 0; ph < N_PHASES; ++ph) { p.ph_lo = ph; p.ph_hi = ph + 1; hipLaunchKernelGGL(mega, dim3(grid), dim3(512), LDS_BYTES, stream, p); }
#else
    p.ph_lo = 0; p.ph_hi = N_PHASES;
    void* args[] = {&p};
    hipError_t e = hipLaunchCooperativeKernel((const void*)mega, dim3(grid), dim3(512), args, LDS_BYTES, stream);
    if (e != hipSuccess) fprintf(stderr, "kernel_launch: cooperative launch failed: %s (grid %d)\n", hipGetErrorString(e), grid);
#endif
}
```

```cpp
#include <hip/hip_runtime.h>
#include <hip/hip_cooperative_groups.h>
#include <cstdio>
#include <cstdint>
namespace cg = cooperative_groups;
__device__ __forceinline__ int TID() { int t = threadIdx.x; asm volatile("" : "+v"(t)); return t; }
__device__ __forceinline__ int BID() { int b = blockIdx.x; asm volatile("" : "+s"(b)); return b; }
#ifndef GEMM_WGM
#define GEMM_WGM 8
#endif
namespace pg8 {
#define PG8_LAS __attribute__((address_space(3)))
typedef unsigned short bf16_t;
typedef short bf16x8 __attribute__((ext_vector_type(8)));
typedef float f32x4 __attribute__((ext_vector_type(4)));
typedef unsigned u32x4 __attribute__((ext_vector_type(4)));
constexpr int BM = 256, BK = 64, HALF = 128, HTB = HALF * BK * 2  , STAGE_BYTES = 8 * HTB, NXCD = 8, WGM = GEMM_WGM;

__host__ __device__ __forceinline__ int lds_byte(int r, int c) { const int st = (r >> 4) * 2 + (c >> 5), rr = r & 15, cc = c & 31, ob = rr * 64 + cc * 2; return st * 1024 + (ob ^ (((ob >> 9) & 1) << 5)); }
__host__ __device__ __forceinline__ void stage_rc(int b, int& R, int& C) { const int st = b / 1024, sb = b % 1024, swz = sb ^ (((sb >> 9) & 1) << 5); R = (st >> 1) * 16 + swz / 64; C = (st & 1) * 32 + (swz % 64) / 2; }
__host__ __device__ __forceinline__ int perm32(int rho) { const int n = rho >> 4, i = rho & 15; return 8 * (i >> 2) + 4 * n + (i & 3); }

struct Unit { int pm, pn; };
struct Gemm { const bf16_t* A; const bf16_t* Bt; int M, N, K; };

struct StaticOrder {
    int nM, nN, nwg, G, c;
    __host__ __device__ void init(int M, int N, int G_, int c_) { nM = M / BM; nN = N / BM; nwg = nM * nN; G = G_; c = c_; }
    __host__ __device__ bool next(int i, Unit& u) const {
        const long L = (long)i * G + c; if (L >= nwg) return false;
        int wgid = (int)L; { const int q = nwg / NXCD, r = nwg % NXCD, xcd = wgid % NXCD, off = wgid / NXCD; wgid = (xcd < r ? xcd * (q + 1) : r * (q + 1) + (xcd - r) * q) + off; }
        const int nig = WGM * nN, gid = wgid / nig, fm = gid * WGM, gsz = (nM - fm) < WGM ? (nM - fm) : WGM;
        u.pm = fm + ((wgid % nig) % gsz); u.pn = (wgid % nig) / gsz; return true;
    }
    __device__ __forceinline__ void a_ready(const Unit&) const {}
    __device__ __forceinline__ void done(const Unit&) const {}
};

__device__ __forceinline__ unsigned cvt_pk_bf16(float lo, float hi) { unsigned r; asm volatile("v_cvt_pk_bf16_f32 %0, %1, %2" : "=v"(r) : "v"(lo), "v"(hi)); return r; }
typedef float f32x2 __attribute__((ext_vector_type(2)));
template <class Epi, class Sched, bool ALIGN_EPI = false, bool SP2 = false>
__device__ __forceinline__ void gemm_phase(PG8_LAS unsigned char* lds, const Gemm g, const Sched& S, const Epi& E) {
    const int tid = TID(), wid = __builtin_amdgcn_readfirstlane(tid >> 6), lane = tid & 63, wr = wid >> 2, wc = wid & 3, fr = lane & 15, fq = lane >> 4;
    const int K = g.K, nt = K / BK;
    unsigned voffA[2], voffB[2];
#pragma unroll
    for (int i = 0; i < 2; ++i) { int R, C; stage_rc(tid * 16 + i * 8192, R, C); const int Rb = Epi::PERM ? ((R & ~31) + perm32(R & 31)) : R;
        voffA[i] = (unsigned)(R * K + C) * 2u; voffB[i] = (unsigned)(Rb * K + C) * 2u; }
    const size_t kstep = (size_t)(BK * 2);
    const size_t hstep = (size_t)HALF * K * 2;
    const size_t tstep = 2 * hstep;
    const unsigned ldsw = (unsigned)wid * 1024u;
    const int aoff = lds_byte(wr * 64 + fr, fq * 8), boff = lds_byte(wc * 32 + fr, fq * 8);
#define PG8_SA(b, h) (((b) * 2 + (h)) * HTB)
#define PG8_SB(b, h) ((4 + (b) * 2 + (h)) * HTB)
#define PG8_STAGE(bufoff, gbase, voff) do { _Pragma("unroll") for (int _i = 0; _i < 2; ++_i) \
        __builtin_amdgcn_global_load_lds((const unsigned*)((const char*)(gbase) + (voff)[_i]), (PG8_LAS unsigned*)(lds + (bufoff) + ldsw + _i * 8192), 16, 0, 0); } while (0)
#define PG8_LDA(dst, b, h) do { _Pragma("unroll") for (int m = 0; m < 4; ++m) _Pragma("unroll") for (int k = 0; k < 2; ++k) dst[m][k] = *(const PG8_LAS bf16x8*)(lds + PG8_SA(b, h) + aoff + m * 2048 + k * 1024); } while (0)
#define PG8_LDB(dst, b, h) do { _Pragma("unroll") for (int n = 0; n < 2; ++n) _Pragma("unroll") for (int k = 0; k < 2; ++k) dst[n][k] = *(const PG8_LAS bf16x8*)(lds + PG8_SB(b, h) + boff + n * 2048 + k * 1024); } while (0)
#define PG8_MMA(ai, bj, At, Bt) do { __builtin_amdgcn_s_setprio(1); _Pragma("unroll") for (int m = 0; m < 4; ++m) _Pragma("unroll") for (int n = 0; n < 2; ++n) _Pragma("unroll") for (int k = 0; k < 2; ++k) \
        acc[ai][bj][m][n] = __builtin_amdgcn_mfma_f32_16x16x32_bf16(Bt[n][k], At[m][k], acc[ai][bj][m][n], 0, 0, 0); __builtin_amdgcn_s_setprio(0); } while (0)
#define PG8_WAIT_V(n) asm volatile("s_waitcnt vmcnt(" #n ")" ::: "memory")
#define PG8_WAIT_L(n) asm volatile("s_waitcnt lgkmcnt(" #n ")" ::: "memory")
#define PG8_BAR __builtin_amdgcn_s_barrier()
#define PG8_SCHED __builtin_amdgcn_sched_barrier(0)
    Unit cur, nxt; int ui = 0;
    if (!S.next(0, cur)) return;
    f32x4 acc[2][2][4][2];
#pragma unroll
    for (int a = 0; a < 2; ++a)
#pragma unroll
        for (int b = 0; b < 2; ++b)
#pragma unroll
            for (int m = 0; m < 4; ++m)
#pragma unroll
                for (int n = 0; n < 2; ++n) acc[a][b][m][n] = (f32x4){0.f, 0.f, 0.f, 0.f};
    bf16x8 At[4][2], B0[2][2], B1[2][2];
    const char* cA = (const char*)g.A + (size_t)cur.pm * tstep; const char* cB = (const char*)g.Bt + (size_t)cur.pn * tstep;
    S.a_ready(cur);
    if constexpr (SP2) {
        PG8_STAGE(PG8_SB(0, 0), cB, voffB); PG8_STAGE(PG8_SB(0, 1), cB + hstep, voffB); PG8_STAGE(PG8_SA(0, 0), cA, voffA); PG8_STAGE(PG8_SA(0, 1), cA + hstep, voffA);
        if (wr == 1) PG8_BAR;
        PG8_WAIT_V(2); PG8_BAR;
        PG8_STAGE(PG8_SB(1, 0), cB + kstep, voffB); PG8_STAGE(PG8_SA(1, 0), cA + kstep, voffA); PG8_STAGE(PG8_SB(1, 1), cB + hstep + kstep, voffB);
        PG8_WAIT_V(6); PG8_BAR;
    } else {
        PG8_STAGE(PG8_SB(0, 0), cB, voffB); PG8_STAGE(PG8_SA(0, 0), cA, voffA); PG8_STAGE(PG8_SB(0, 1), cB + hstep, voffB); PG8_STAGE(PG8_SA(0, 1), cA + hstep, voffA);
        if (wr == 1) PG8_BAR;
        PG8_WAIT_V(4); PG8_BAR;
        PG8_STAGE(PG8_SB(1, 0), cB + kstep, voffB); PG8_STAGE(PG8_SA(1, 0), cA + kstep, voffA); PG8_STAGE(PG8_SB(1, 1), cB + hstep + kstep, voffB);
        PG8_WAIT_V(6); PG8_BAR;
    }
    for (;;) {
        const bool has_next = S.next(ui + 1, nxt);
        const char* nA = has_next ? (const char*)g.A + (size_t)nxt.pm * tstep : cA; const char* nB = has_next ? (const char*)g.Bt + (size_t)nxt.pn * tstep : cB;
        for (int t = 0; t < nt; t += 2) {
            const bool last = (t == nt - 2);
            const char* a1 = cA + (size_t)(t + 1) * kstep;
            const char* a2 = last ? nA : cA + (size_t)(t + 2) * kstep; const char* b2 = last ? nB : cB + (size_t)(t + 2) * kstep;
            const char* a3 = a2 + kstep; const char* b3 = b2 + kstep;
            if (last && has_next) S.a_ready(nxt);
            if constexpr (SP2) {
            PG8_LDB(B0, 0, 0); PG8_LDB(B1, 0, 1); PG8_SCHED; PG8_LDA(At, 0, 0); PG8_STAGE(PG8_SA(1, 1), a1 + hstep, voffA);
            PG8_WAIT_V(8); PG8_WAIT_L(0); PG8_BAR; PG8_MMA(0, 0, At, B0); PG8_MMA(0, 1, At, B1); PG8_BAR; PG8_SCHED;
            PG8_LDA(At, 0, 1); PG8_STAGE(PG8_SB(0, 0), b2, voffB); PG8_STAGE(PG8_SB(0, 1), b2 + hstep, voffB); PG8_STAGE(PG8_SA(0, 0), a2, voffA);
            PG8_WAIT_V(8); PG8_WAIT_L(0); PG8_BAR; PG8_MMA(1, 0, At, B0); PG8_MMA(1, 1, At, B1); PG8_BAR; PG8_SCHED;
            PG8_LDB(B0, 1, 0); PG8_LDB(B1, 1, 1); PG8_SCHED; PG8_LDA(At, 1, 0); PG8_STAGE(PG8_SA(0, 1), a2 + hstep, voffA);
            PG8_WAIT_V(8); PG8_WAIT_L(0); PG8_BAR; PG8_MMA(0, 0, At, B0); PG8_MMA(0, 1, At, B1); PG8_BAR; PG8_SCHED;
            PG8_LDA(At, 1, 1); PG8_STAGE(PG8_SB(1, 0), b3, voffB); PG8_STAGE(PG8_SB(1, 1), b3 + hstep, voffB); PG8_STAGE(PG8_SA(1, 0), a3, voffA);
            PG8_WAIT_V(8); PG8_WAIT_L(0); PG8_BAR; PG8_MMA(1, 0, At, B0); PG8_MMA(1, 1, At, B1); PG8_BAR; PG8_SCHED;
            } else {
            PG8_LDB(B0, 0, 0); PG8_SCHED; PG8_LDA(At, 0, 0); PG8_STAGE(PG8_SA(1, 1), a1 + hstep, voffA);
            PG8_WAIT_L(8); PG8_BAR; PG8_WAIT_L(0); PG8_MMA(0, 0, At, B0); PG8_BAR; PG8_SCHED;
            PG8_LDB(B1, 0, 1); PG8_STAGE(PG8_SB(0, 0), b2, voffB);
            PG8_BAR; PG8_WAIT_L(0); PG8_MMA(0, 1, At, B1); PG8_BAR;
            PG8_LDA(At, 0, 1); PG8_STAGE(PG8_SA(0, 0), a2, voffA);
            PG8_BAR; PG8_WAIT_L(0); PG8_MMA(1, 0, At, B0); PG8_BAR; PG8_SCHED;
            PG8_STAGE(PG8_SB(0, 1), b2 + hstep, voffB);
            PG8_WAIT_V(6); PG8_BAR; PG8_MMA(1, 1, At, B1); PG8_BAR;
            PG8_LDB(B0, 1, 0); PG8_SCHED; PG8_LDA(At, 1, 0); PG8_STAGE(PG8_SA(0, 1), a2 + hstep, voffA);
            PG8_WAIT_L(8); PG8_BAR; PG8_WAIT_L(0); PG8_MMA(0, 0, At, B0); PG8_BAR; PG8_SCHED;
            PG8_LDB(B1, 1, 1); PG8_STAGE(PG8_SB(1, 0), b3, voffB);
            PG8_BAR; PG8_WAIT_L(0); PG8_MMA(0, 1, At, B1); PG8_BAR;
            PG8_LDA(At, 1, 1); PG8_STAGE(PG8_SA(1, 0), a3, voffA);
            PG8_BAR; PG8_WAIT_L(0); PG8_MMA(1, 0, At, B0); PG8_BAR; PG8_SCHED;
            PG8_STAGE(PG8_SB(1, 1), b3 + hstep, voffB);
            PG8_WAIT_V(6); PG8_BAR; PG8_MMA(1, 1, At, B1); PG8_BAR;
            }
        }
        if constexpr (ALIGN_EPI) { if (wr == 0) PG8_BAR; }
        if constexpr (!Epi::AFTER_DRAIN) { E(acc, cur, wr, wc, fr, fq); S.done(cur); }
        if (!has_next) break;
#pragma unroll
        for (int a = 0; a < 2; ++a)
#pragma unroll
            for (int b = 0; b < 2; ++b)
#pragma unroll
                for (int m = 0; m < 4; ++m)
#pragma unroll
                    for (int n = 0; n < 2; ++n) acc[a][b][m][n] = (f32x4){0.f, 0.f, 0.f, 0.f};
        cur = nxt; cA = nA; cB = nB; ++ui;
        if constexpr (ALIGN_EPI) { if (wr == 1) PG8_BAR; }
    }
    PG8_WAIT_V(0);
    if constexpr (!ALIGN_EPI) { if (wr == 0) PG8_BAR; }
    PG8_BAR;
    if constexpr (Epi::AFTER_DRAIN) { E.fused(acc, cur, wr, wc, fr, fq, lds, wid, lane); S.done(cur); }
#undef PG8_SA
#undef PG8_SB
#undef PG8_STAGE
#undef PG8_LDA
#undef PG8_LDB
#undef PG8_MMA
#undef PG8_WAIT_V
#undef PG8_WAIT_L
#undef PG8_BAR
#undef PG8_SCHED
}
}
#define LAS __attribute__((address_space(3)))
#define XB_TMO      128
#define XB_XCNT(j)  (256  + 64 * (j))
#define XB_XSUB(j)  (1280 + 64 * (j))
#define XB_XGEN(j)  (2304 + 64 * (j))
#define XB_TOP      3328
#define XB_TOPGEN   3392
#define XCD_BAR_WORDS 3456
#define XB_SPIN_CAP (1u << 18)

__device__ __forceinline__ unsigned xb_ld(unsigned* p)              { return __hip_atomic_load(p, __ATOMIC_RELAXED, __HIP_MEMORY_SCOPE_AGENT); }
__device__ __forceinline__ unsigned xb_add(unsigned* p, unsigned v) { return __hip_atomic_fetch_add(p, v, __ATOMIC_RELAXED, __HIP_MEMORY_SCOPE_AGENT); }
__device__ __forceinline__ unsigned xb_xcc_id() { return (unsigned)__builtin_amdgcn_s_getreg((3 << 11) | 20) & 0xFu; }
#define XB_SPIN(cond, bar) do { unsigned _sp = 0; while (cond) { __builtin_amdgcn_s_sleep(1); \
    if ((++_sp & 255u) == 0u) { if (xb_ld(&(bar)[XB_TMO])) break; if (_sp > XB_SPIN_CAP) { atomicAdd(&(bar)[XB_TMO], 1u); break; } } } } while (0)

struct XcdBarrier {
    unsigned* bar; unsigned x;
    volatile LAS unsigned* st;
};

__device__ __forceinline__ XcdBarrier xcd_barrier_post(unsigned* bar, volatile LAS unsigned* st) {
    XcdBarrier b; b.bar = bar; b.x = xb_xcc_id(); b.st = st;
    if (threadIdx.x == 0) (void)xb_add(&bar[XB_XCNT(b.x)], 1u);
    return b;
}
__device__ __forceinline__ void xcd_barrier_complete(unsigned* bar, unsigned x, unsigned& nloc, unsigned& nx) {
    const unsigned G = gridDim.x * gridDim.y * gridDim.z;
    unsigned sum, cnt, mine, sp = 0u;
    for (;;) {
        sum = 0u; cnt = 0u; mine = 0u;
#pragma unroll
        for (unsigned j = 0; j < 16; ++j) { const unsigned c = xb_ld(&bar[XB_XCNT(j)]); sum += c; cnt += (c > 0u) ? 1u : 0u; mine = (j == x) ? c : mine; }
        if (sum == G) break;
        __builtin_amdgcn_s_sleep(1);
        if ((++sp & 255u) == 0u) { if (xb_ld(&bar[XB_TMO])) break; if (sp > XB_SPIN_CAP) { atomicAdd(&bar[XB_TMO], 1u); break; } }
    }
    nloc = mine > 0u ? mine : 1u; nx = cnt > 0u ? cnt : 1u;
}

__device__ __forceinline__ void xcd_barrier(const XcdBarrier& b) {
    asm volatile("s_waitcnt vmcnt(0)" ::: "memory");
    __syncthreads();
    if (threadIdx.x == 0) {
        unsigned* bar = b.bar;
        __builtin_amdgcn_s_waitcnt(0);
        unsigned nloc = b.st[0], nx = b.st[1];
        if (nloc == 0u) { xcd_barrier_complete(bar, b.x, nloc, nx); b.st[0] = nloc; b.st[1] = nx; }
        const unsigned old = xb_add(&bar[XB_XSUB(b.x)], 1u);
        const unsigned gen = old / nloc;
        if (old + 1u == (gen + 1u) * nloc) {
            __builtin_amdgcn_fence(__ATOMIC_RELEASE, "agent");
            asm volatile("s_waitcnt vmcnt(0)" ::: "memory");
            const unsigned og = xb_add(&bar[XB_TOP], 1u);
            const unsigned tg = og / nx;
            if (og + 1u == (tg + 1u) * nx) xb_add(&bar[XB_TOPGEN], 1u);
            else XB_SPIN(xb_ld(&bar[XB_TOPGEN]) == tg, bar);
            __builtin_amdgcn_fence(__ATOMIC_ACQUIRE, "agent");
            xb_add(&bar[XB_XGEN(b.x)], 1u);
            asm volatile("s_waitcnt vmcnt(0)" ::: "memory");
        } else {
            XB_SPIN(xb_ld(&bar[XB_XGEN(b.x)]) == gen, bar);
            __builtin_amdgcn_fence(__ATOMIC_ACQUIRE, "agent");
            asm volatile("s_waitcnt vmcnt(0)" ::: "memory");
        }
    }
    __syncthreads();
}
#ifndef PROBE
#define PROBE 0
#endif

using pg8::bf16_t; using pg8::bf16x8; using pg8::f32x4; using pg8::u32x4; using pg8::cvt_pk_bf16;

typedef unsigned u32x2 __attribute__((ext_vector_type(2)));
typedef float f32x2v __attribute__((ext_vector_type(2)));

constexpr int T = 32768, D = 1024, DFF = 2816, SEQ = 16384;
constexpr int LDS_BYTES = 151552;
constexpr float EPS = 1e-6f;
constexpr size_t MiB = 1ull << 20;
constexpr size_t OFF_W = 0;
constexpr size_t OFF_R1 = 52 * MiB;
constexpr size_t OFF_YH = OFF_R1 + 192 * MiB;
constexpr size_t OFF_MOD = OFF_YH + 64 * MiB;
constexpr size_t OFF_PART = OFF_MOD + 256 * 1024;
constexpr size_t OFF_BAR = OFF_PART + 6 * MiB;
constexpr size_t OFF_R2 = OFF_BAR + 16384;
constexpr int LDV = T + 64;
constexpr size_t WS_END = OFF_R2 + 193 * MiB;
constexpr size_t W_IN0 = 0, W_IN1 = (size_t)2 * DFF * D, W_OUT0 = (size_t)4 * DFF * D, W_OUT1 = W_OUT0 + (size_t)D * DFF, W_X = W_OUT1 + (size_t)D * DFF;
constexpr size_t W_HGOUT = W_X + (size_t)4096 * D, W_GMOUT = W_X + (size_t)6144 * D;

struct Params {
    const float* in[19];
    float* out; unsigned char* ws;
    int ph_lo, ph_hi;
};
#define CAS __attribute__((address_space(4)))
__device__ __forceinline__ const CAS Params* KP() { const CAS Params* q = (const CAS Params*)__builtin_amdgcn_kernarg_segment_ptr(); asm volatile("" : "+s"(q)); return q; }

__device__ __forceinline__ float frcp(float x) { return __builtin_amdgcn_rcpf(x); }
__device__ __forceinline__ float fexp(float x) { return __builtin_amdgcn_exp2f(x * 1.4426950408889634f); }
__device__ __forceinline__ float flog(float x) { return __builtin_amdgcn_logf(x) * 0.6931471805599453f; }
__device__ __forceinline__ float silu_f(float x) { return x * frcp(1.f + fexp(-x)); }
__device__ __forceinline__ float gelu_f(float x) { const float u = 1.5957691216f * (x + 0.044715f * x * x * x); return x * frcp(1.f + fexp(-u)); }
__device__ __forceinline__ f32x4 sigmoid4(const f32x4 x) {
    f32x4 r;
#pragma unroll
    for (int j = 0; j < 4; ++j) r[j] = __builtin_amdgcn_rcpf(1.f + __builtin_amdgcn_exp2f(x[j] * -1.4426950408889634f));
    return r;
}
__device__ __forceinline__ f32x4 silu4(const f32x4 x) { return x * sigmoid4(x); }
__device__ __forceinline__ f32x4 gelu4(const f32x4 x) { const f32x4 u = (x + x * x * x * 0.044715f) * 1.5957691216f; return x * sigmoid4(u); }
typedef _Float16 f16x2 __attribute__((ext_vector_type(2)));
__device__ __forceinline__ unsigned pk_h2(float a, float b) { f16x2 v; v.x = (_Float16)a; v.y = (_Float16)b; return __builtin_bit_cast(unsigned, v); }
__device__ __forceinline__ float h_lo(unsigned w) { return (float)__builtin_bit_cast(f16x2, w).x; }
__device__ __forceinline__ float h_hi(unsigned w) { return (float)__builtin_bit_cast(f16x2, w).y; }
__device__ __forceinline__ float bf_lo(unsigned w) { return __uint_as_float(w << 16); }
__device__ __forceinline__ float bf_hi(unsigned w) { return __uint_as_float(w & 0xffff0000u); }
__device__ __forceinline__ float bf1(unsigned short h) { return __uint_as_float(((unsigned)h) << 16); }
__device__ __forceinline__ u32x4 pack8(const f32x4 a, const f32x4 b) { u32x4 w; w.x = cvt_pk_bf16(a[0], a[1]); w.y = cvt_pk_bf16(a[2], a[3]); w.z = cvt_pk_bf16(b[0], b[1]); w.w = cvt_pk_bf16(b[2], b[3]); return w; }
#define DPP_ADD(v_, ctrl_, rm_) v_ += __builtin_bit_cast(float, __builtin_amdgcn_update_dpp(0, __builtin_bit_cast(int, v_), ctrl_, rm_, 0xF, false))
__device__ __forceinline__ float wave_sum(float v) {
    DPP_ADD(v, 0xB1, 0xF);
    DPP_ADD(v, 0x4E, 0xF);
    DPP_ADD(v, 0x141, 0xF);
    DPP_ADD(v, 0x140, 0xF);
    DPP_ADD(v, 0x142, 0xA);
    DPP_ADD(v, 0x143, 0xC);
    return __builtin_bit_cast(float, __builtin_amdgcn_readlane(__builtin_bit_cast(int, v), 63));
}
#define LDS_WAIT() asm volatile("s_waitcnt lgkmcnt(0)" ::: "memory")
#define LDS_BARRIER() do { asm volatile("s_waitcnt lgkmcnt(0)" ::: "memory"); __builtin_amdgcn_s_barrier(); asm volatile("" ::: "memory"); } while (0)

struct Epi {
    static constexpr bool PERM = true, AFTER_DRAIN = false;
    int mode_in;
    __device__ __forceinline__ void operator()(const f32x4 (&acc)[2][2][4][2], const pg8::Unit& u_in, int wr, int wc, int fr, int fq) const {
        if (mode_in == 7) return;
        const CAS Params* kp = KP();
        unsigned char* ws = kp->ws;
        pg8::Unit u = u_in; const int mode = mode_in & 7;
        if (mode_in & 8) { u.pm = 0; u.pn = u_in.pn & 3; }
        const int row0 = u.pm * 256 + wr * 64 + fr;
        if (mode == 0) {
            bf16_t* o0 = (bf16_t*)(ws + OFF_YH); constexpr int ldc = D;
            const int col0 = u.pn * 256 + wc * 32 + 8 * fq;
#pragma unroll
            for (int ai = 0; ai < 2; ++ai)
#pragma unroll
                for (int m = 0; m < 4; ++m) { bf16_t* rowp = o0 + (size_t)(row0 + ai * 128 + m * 16) * ldc + col0;
#pragma unroll
                    for (int bj = 0; bj < 2; ++bj) *(u32x4*)(rowp + bj * 128) = pack8(acc[ai][bj][m][0], acc[ai][bj][m][1]); }
        } else if (mode == 1) {
            bf16_t* o0 = (bf16_t*)(ws + OFF_R1); constexpr int ldc = DFF;
            const int col0 = u.pn * 128 + wc * 32 + 8 * fq;
#pragma unroll
            for (int ai = 0; ai < 2; ++ai)
#pragma unroll
                for (int m = 0; m < 4; ++m) { bf16_t* rowp = o0 + (size_t)(row0 + ai * 128 + m * 16) * ldc + col0;
                    const f32x4 r0 = silu4(acc[ai][0][m][0]) * acc[ai][1][m][0], r1 = silu4(acc[ai][0][m][1]) * acc[ai][1][m][1];
                    *(u32x4*)rowp = pack8(r0, r1); }
        } else if (mode == 2) {
            bf16_t* o0 = (bf16_t*)(ws + OFF_R1); bf16_t* o1 = (bf16_t*)(ws + OFF_R1 + 64 * MiB); bf16_t* o2 = (bf16_t*)(ws + OFF_R1 + 128 * MiB); bf16_t* o3 = (bf16_t*)(ws + OFF_R2 + 128 * MiB);
            bf16_t* f0 = (bf16_t*)(ws + OFF_R2); const float* p0 = kp->in[11];
            const int sect = u.pn >> 2;
            const int col0 = (u.pn & 3) * 256 + wc * 32 + 8 * fq;
            if (sect == 1) {
#pragma unroll
                for (int bj = 0; bj < 2; ++bj) {
                    const int c = col0 + bj * 128;
                    f32x4 lbv[2], omv[2];
#pragma unroll
                    for (int n = 0; n < 2; ++n) {
                        const f32x4 a0 = *(const f32x4*)(p0 + c + 4 * n), a1 = *(const f32x4*)(p0 + 1024 + c + 4 * n), a2 = *(const f32x4*)(p0 + 2048 + c + 4 * n);
#pragma unroll
                        for (int j = 0; j < 4; ++j) { const float mx = fmaxf(a0[j], fmaxf(a1[j], a2[j])); const float e0 = fexp(a0[j] - mx), e1 = fexp(a1[j] - mx), e2 = fexp(a2[j] - mx);
                            const float lb = e0 / (e0 + e1 + e2); lbv[n][j] = lb; omv[n][j] = 1.f - lb; }
                    }
#pragma unroll
                    for (int ai = 0; ai < 2; ++ai)
#pragma unroll
                        for (int m = 0; m < 4; ++m) { const size_t off = (size_t)(row0 + ai * 128 + m * 16) * 1024 + c;
                            f32x4 l0, l1;
                            const f32x4 g0 = sigmoid4(acc[ai][bj][m][0]), g1 = sigmoid4(acc[ai][bj][m][1]);
#pragma unroll
                            for (int j = 0; j < 4; ++j) { l0[j] = flog(lbv[0][j] + omv[0][j] * g0[j]); l1[j] = flog(lbv[1][j] + omv[1][j] * g1[j]); }
                            { u32x4 lw; lw.x = pk_h2(l0[0], l0[1]); lw.y = pk_h2(l0[2], l0[3]); lw.z = pk_h2(l1[0], l1[1]); lw.w = pk_h2(l1[2], l1[3]); *(u32x4*)(f0 + off) = lw; }
                            }
                }
            } else {
                bf16_t* dst = sect == 0 ? o0 : (sect == 2 ? o2 : o3);
                const bool act = sect != 2;
#pragma unroll
                for (int ai = 0; ai < 2; ++ai)
#pragma unroll
                    for (int m = 0; m < 4; ++m) { bf16_t* rowp = dst + (size_t)(row0 + ai * 128 + m * 16) * 1024 + col0;
#pragma unroll
                        for (int bj = 0; bj < 2; ++bj) { f32x4 v0 = acc[ai][bj][m][0], v1 = acc[ai][bj][m][1];
                            if (act) { v0 = silu4(v0); v1 = silu4(v1); }
                            *(u32x4*)(rowp + bj * 128) = pack8(v0, v1); } }
            }
        } else if (mode == 3) {
            bf16_t* o0 = (bf16_t*)(ws + OFF_R1); constexpr int ldc = 3072; const float* p0 = kp->in[13];
            const int col0 = u.pn * 256 + wc * 32 + 8 * fq;
            f32x4 bv[2][2];
#pragma unroll
            for (int bj = 0; bj < 2; ++bj)
#pragma unroll
                for (int n = 0; n < 2; ++n) bv[bj][n] = *(const f32x4*)(p0 + col0 + bj * 128 + 4 * n);
            u32x4 qc[2], qn[2];
            qc[0] = *(const u32x4*)(o0 + (size_t)row0 * ldc + col0); qc[1] = *(const u32x4*)(o0 + (size_t)row0 * ldc + col0 + 128); qn[0] = qc[0]; qn[1] = qc[1];
#pragma unroll
            for (int ai = 0; ai < 2; ++ai)
#pragma unroll
                for (int m = 0; m < 4; ++m) { bf16_t* rowp = o0 + (size_t)(row0 + ai * 128 + m * 16) * ldc + col0;
                    if (ai * 4 + m < 7) { const int nx = ai * 4 + m + 1; const bf16_t* np = o0 + (size_t)(row0 + (nx >> 2) * 128 + (nx & 3) * 16) * ldc + col0; qn[0] = *(const u32x4*)np; qn[1] = *(const u32x4*)(np + 128); }
                    asm volatile("" : "+v"(qc[0]), "+v"(qc[1]));
#pragma unroll
                    for (int bj = 0; bj < 2; ++bj) { f32x4 v0 = acc[ai][bj][m][0] + bv[bj][0], v1 = acc[ai][bj][m][1] + bv[bj][1];
                        const u32x4 q = qc[bj];
                        v0 = gelu4(v0) * (f32x4){bf_lo(q.x), bf_hi(q.x), bf_lo(q.y), bf_hi(q.y)}; v1 = gelu4(v1) * (f32x4){bf_lo(q.z), bf_hi(q.z), bf_lo(q.w), bf_hi(q.w)};
                        *(u32x4*)(rowp + bj * 128) = pack8(v0, v1); }
                    qc[0] = qn[0]; qc[1] = qn[1]; }
        } else {
            bf16_t* o0 = (bf16_t*)(ws + OFF_R2); constexpr int ldc = LDV; const float* p0 = kp->in[13] + 3072; float* part = (float*)(ws + OFF_PART);
            const int col0 = u.pn * 256 + wc * 32 + 8 * fq;
            f32x4 s[2][2], q[2][2];
#pragma unroll
            for (int bj = 0; bj < 2; ++bj)
#pragma unroll
                for (int n = 0; n < 2; ++n) { s[bj][n] = (f32x4){0.f, 0.f, 0.f, 0.f}; q[bj][n] = (f32x4){0.f, 0.f, 0.f, 0.f}; }
            float bv8[8];
#pragma unroll
            for (int i8 = 0; i8 < 8; ++i8) bv8[i8] = p0[row0 + (i8 >> 2) * 128 + (i8 & 3) * 16];
#pragma unroll
            for (int ai = 0; ai < 2; ++ai)
#pragma unroll
                for (int m = 0; m < 4; ++m) { const int row = row0 + ai * 128 + m * 16; const float bv = bv8[ai * 4 + m]; bf16_t* rowp = o0 + ((size_t)(u.pn * 2) * 3072 + row) * 128 + wc * 32 + 8 * fq;
#pragma unroll
                    for (int bj = 0; bj < 2; ++bj) { f32x4 v0 = acc[ai][bj][m][0] + bv, v1 = acc[ai][bj][m][1] + bv;
                        v0 = gelu4(v0); v1 = gelu4(v1);
                        s[bj][0] += v0; s[bj][1] += v1; q[bj][0] += v0 * v0; q[bj][1] += v1 * v1;
                        *(u32x4*)(rowp + (size_t)bj * 3072 * 128) = pack8(v0, v1); } }
#pragma unroll
            for (int bj = 0; bj < 2; ++bj)
#pragma unroll
                for (int n = 0; n < 2; ++n)
#pragma unroll
                    for (int j = 0; j < 4; ++j) {
                        { float sv = s[bj][n][j], qv = q[bj][n][j];
                          DPP_ADD(sv, 0xB1, 0xF); DPP_ADD(qv, 0xB1, 0xF); DPP_ADD(sv, 0x4E, 0xF); DPP_ADD(qv, 0x4E, 0xF); DPP_ADD(sv, 0x141, 0xF); DPP_ADD(qv, 0x141, 0xF); DPP_ADD(sv, 0x140, 0xF); DPP_ADD(qv, 0x140, 0xF);
                          s[bj][n][j] = sv; q[bj][n][j] = qv; } }
            if (fr == 0) {
                float* pp = part + ((size_t)(u.pm * 2 + wr) * T + col0) * 2;
#pragma unroll
                for (int bj = 0; bj < 2; ++bj)
#pragma unroll
                    for (int n = 0; n < 2; ++n) {
                        *(f32x4*)(pp + (bj * 128 + 4 * n) * 2) = (f32x4){s[bj][n][0], q[bj][n][0], s[bj][n][1], q[bj][n][1]};
                        *(f32x4*)(pp + (bj * 128 + 4 * n) * 2 + 4) = (f32x4){s[bj][n][2], q[bj][n][2], s[bj][n][3], q[bj][n][3]}; }
            }
        }
        if (PROBE == 16) asm volatile("s_waitcnt vmcnt(0)" ::: "memory");
    }
};

__device__ __forceinline__ void tp_params(const CAS Params* kp, int L, bf16_t* Wb, int it, int lane, const float*& sp, int& N, bf16_t*& dp, int& K) {
    const int nA = 2816, nB = 1408, nC = L == 0 ? 2048 : 3072;
    int r = it; const float* src; bf16_t* dst; int swz = 0;
    if (r < nA) { src = kp->in[6] + (size_t)(L * 2 + 0) * D * 2 * DFF; K = D; N = 2 * DFF; dst = Wb + W_IN0; swz = 1; }
    else if ((r -= nA) < nA) { src = kp->in[6] + (size_t)(L * 2 + 1) * D * 2 * DFF; K = D; N = 2 * DFF; dst = Wb + W_IN1; swz = 1; }
    else if ((r -= nA) < nB) { src = kp->in[7] + (size_t)(L * 2 + 0) * DFF * D; K = DFF; N = D; dst = Wb + W_OUT0; }
    else if ((r -= nB) < nB) { src = kp->in[7] + (size_t)(L * 2 + 1) * DFF * D; K = DFF; N = D; dst = Wb + W_OUT1; }
    else if ((r -= nB) < nC) { src = L == 0 ? kp->in[8] : kp->in[12]; K = D; N = L == 0 ? 4096 : 6144; dst = Wb + W_X; }
    else { r -= nC; src = L == 0 ? kp->in[9] : kp->in[18]; K = L == 0 ? D : 3072; N = D; dst = L == 0 ? Wb + W_HGOUT : Wb + W_GMOUT; }
    const int nblk = N >> 5, kb = r / nblk, nb = r - kb * nblk;
    const int dstrow0 = nb * 32, k0 = kb * 64;
    const int srccol0 = swz ? (((dstrow0 & 128) ? DFF : 0) + (dstrow0 >> 8) * 128 + (dstrow0 & 127)) : dstrow0;
    sp = src + (size_t)(k0 + (lane >> 5)) * N + srccol0 + (lane & 31);
    dp = dst + (size_t)(dstrow0 + (lane >> 3)) * K + k0 + 8 * (lane & 7);
}
__device__ __forceinline__ void tp_finish(const float (&R)[32], bf16_t* dp, int K, LAS float* scr, int lane) {
#pragma unroll
    for (int i = 0; i < 32; ++i) scr[(2 * i + (lane >> 5)) * 33 + (lane & 31)] = R[i];
    LDS_WAIT(); asm volatile("" ::: "memory");
    const int c = lane & 7;
    float tv[4][8];
#pragma unroll
    for (int j = 0; j < 4; ++j) { const LAS float* s = scr + (8 * c) * 33 + (lane >> 3) + 8 * j;
#pragma unroll
        for (int e8 = 0; e8 < 8; ++e8) tv[j][e8] = s[e8 * 33]; }
#pragma unroll
    for (int j = 0; j < 4; ++j) {
        u32x4 o; o.x = cvt_pk_bf16(tv[j][0], tv[j][1]); o.y = cvt_pk_bf16(tv[j][2], tv[j][3]); o.z = cvt_pk_bf16(tv[j][4], tv[j][5]); o.w = cvt_pk_bf16(tv[j][6], tv[j][7]);
        *(u32x4*)(dp + (size_t)(8 * j) * K) = o; }
    LDS_WAIT(); asm volatile("" ::: "memory");
}
__device__ __forceinline__ void prep_weights(LAS unsigned char* lds, int L) {
    const CAS Params* kp = KP();
    const int lane = TID() & 63, wave = TID() >> 6;
    LAS float* scr = (LAS float*)(lds + wave * 8448);
    bf16_t* Wb = (bf16_t*)(kp->ws + OFF_W);
    const int gw = BID() * 8 + wave, NGW = gridDim.x * 8;
    const int total = 2 * 2816 + 2 * 1408 + (L == 0 ? 2048 + 512 : 3072 + 1536);
    for (int it = gw; it < total; it += 2 * NGW) {
        const bool hasB = it + NGW < total;
        const float *spA, *spB; bf16_t *dpA, *dpB; int NA, NB, KA, KB;
        tp_params(kp, L, Wb, it, lane, spA, NA, dpA, KA);
        tp_params(kp, L, Wb, hasB ? it + NGW : it, lane, spB, NB, dpB, KB);
        float RA[32], RB[32];
#pragma unroll
        for (int i = 0; i < 32; ++i) RA[i] = spA[(size_t)(2 * i) * NA];
#pragma unroll
        for (int i = 0; i < 32; ++i) RB[i] = hasB ? spB[(size_t)(2 * i) * NB] : 0.f;
        tp_finish(RA, dpA, KA, scr, lane);
        if (hasB) tp_finish(RB, dpB, KB, scr, lane);
    }
}
__device__ __forceinline__ void mod_gemv(LAS unsigned char* lds) {
    const CAS Params* kp = KP(); const float* cin = kp->in[1]; const float* adaw = kp->in[2]; const float* adab = kp->in[3];
    const int tid = TID(), lane = tid & 63, wave = tid >> 6;
    LAS float* cond = (LAS float*)(lds + 73728);
    LAS float* red = (LAS float*)(lds + 73728 + 8192);
    float* mod = (float*)(kp->ws + OFF_MOD);
    __syncthreads();
    for (int i = tid; i < 2048; i += 512) cond[i] = silu_f(cin[i]);
    __syncthreads();
    for (int it = BID(); it < 288; it += gridDim.x) {
        const int col = it * 64 + lane, l = col / 9216, n = col - l * 9216;
        const float* w = adaw + (size_t)l * D * 9216 + n;
        const int k0 = wave * 128;
        float a0 = 0.f, a1 = 0.f;
#pragma unroll 32
        for (int k = 0; k < 128; ++k) { const float wv = w[(size_t)(k0 + k) * 9216]; a0 += cond[k0 + k] * wv; a1 += cond[1024 + k0 + k] * wv; }
        red[(wave * 2 + 0) * 64 + lane] = a0; red[(wave * 2 + 1) * 64 + lane] = a1;
        __syncthreads();
        if (tid < 128) { const int b = tid >> 6, ln = tid & 63; float s = 0.f;
#pragma unroll
            for (int w8 = 0; w8 < 8; ++w8) s += red[(w8 * 2 + b) * 64 + ln];
            const int col2 = it * 64 + ln, l2 = col2 / 9216, n2 = col2 - l2 * 9216;
            mod[(size_t)(l2 * 2 + b) * 9216 + n2] = s + adab[l2 * 9216 + n2]; }
        __syncthreads();
    }
}

#ifndef XBF16
#define XBF16 1
#endif
__device__ __forceinline__ void norm_phase(int upd_l, int upd_s, int h_l, int h_s, int xsrc, int xdst, bool dummy, int vc) {
    const CAS Params* kp = KP(); unsigned char* ws = kp->ws; const float* npre = kp->in[4]; const float* npost = kp->in[5];
    const unsigned char* xin = xsrc == 0 ? (const unsigned char*)kp->in[0] : (xsrc == 1 || !XBF16) ? (const unsigned char*)kp->out : (const unsigned char*)(ws + OFF_R2);
    unsigned char* xout = dummy ? (ws + OFF_R2 + 64 * MiB) : ((xdst == 2 && XBF16) ? (ws + OFF_R2) : (unsigned char*)kp->out);
    const bool in_f32 = !XBF16 || xsrc == 0, out_f32 = !XBF16 || xdst == 3;
    const int lane = TID() & 63, wave = TID() >> 6;
#ifndef PROBE
#define PROBE 0
#endif
    const int bid_ = BID();
    if (PROBE == 15 && ((bid_ >> 3) & 1)) return;
    const int gw = (PROBE == 15 ? ((bid_ & 7) + 8 * (bid_ >> 4)) : bid_) * 8 + wave, NGW = (PROBE == 15 ? gridDim.x / 2 : gridDim.x) * 8;
    const float* mod = (const float*)(ws + OFF_MOD);
    const bf16_t* y = (const bf16_t*)(ws + OFF_YH);
    bf16_t* h = dummy ? (bf16_t*)(ws + OFF_R2 + 128 * MiB) : (bf16_t*)(ws + OFF_YH);
    const bool upd = upd_l >= 0, hh = h_l >= 0;
    const bool aff = gridDim.x == 256 && PROBE != 15;
    const int ax = vc & 7, aj = vc >> 3;
    for (int b = 0; b < 2; ++b) {
        if (aff && b != (ax >> 2)) continue;
        f32x4 A1[4], A2[4], A3[4];
#pragma unroll
        for (int j = 0; j < 4; ++j) { A1[j] = (f32x4){0.f, 0.f, 0.f, 0.f}; A2[j] = A1[j]; A3[j] = A1[j]; }
        if (upd) { const float rw = upd_s == 1 ? 1.0f : 0.5f;
            const f32x4* gate = (const f32x4*)(mod + ((size_t)(upd_l * 2 + b) * 9 + 3 * upd_s + 2) * D) + lane; const f32x4* post = (const f32x4*)(npost + (size_t)(upd_l * 3 + upd_s) * D) + lane;
#pragma unroll
            for (int j = 0; j < 4; ++j) A1[j] = gate[64 * j] * post[64 * j] * rw; }
        if (hh) { const f32x4* shift = (const f32x4*)(mod + ((size_t)(h_l * 2 + b) * 9 + 3 * h_s + 0) * D) + lane; const f32x4* scale = (const f32x4*)(mod + ((size_t)(h_l * 2 + b) * 9 + 3 * h_s + 1) * D) + lane;
            const f32x4* pre = (const f32x4*)(npre + (size_t)(h_l * 3 + h_s) * D) + lane;
#pragma unroll
            for (int j = 0; j < 4; ++j) { A2[j] = pre[64 * j] * (scale[64 * j] + 1.0f); A3[j] = shift[64 * j]; } }
        f32x4 v0[4], v1[4], v2[4], v3[4]; u32x2 xb0[4], xb1[4], xb2[4], xb3[4], yb0[4], yb1[4], yb2[4], yb3[4];
#define NP_LOAD(ROW_, V_, XB_, YB_) do { \
            if (in_f32) { const f32x4* xr_ = (const f32x4*)(xin + (size_t)(ROW_) * D * 4) + lane; _Pragma("unroll") for (int j = 0; j < 4; ++j) V_[j] = xr_[64 * j]; } \
            else { const u32x2* xr_ = (const u32x2*)(xin + (size_t)(ROW_) * D * 2) + lane; _Pragma("unroll") for (int j = 0; j < 4; ++j) XB_[j] = xr_[64 * j]; } \
            if (upd) { const u32x2* yr_ = (const u32x2*)(y + (size_t)(ROW_) * D) + lane; _Pragma("unroll") for (int j = 0; j < 4; ++j) YB_[j] = yr_[64 * j]; } } while (0)
#define NP_PROC(ROW_, V_, XB_, YB_) do { \
            if (!in_f32) { _Pragma("unroll") for (int j = 0; j < 4; ++j) V_[j] = (f32x4){h_lo(XB_[j].x), h_hi(XB_[j].x), h_lo(XB_[j].y), h_hi(XB_[j].y)}; } \
            if (upd) { \
                f32x4 yv[4]; float ss = 0.f; \
                _Pragma("unroll") for (int j = 0; j < 4; ++j) { const u32x2 w = YB_[j]; yv[j] = (f32x4){bf_lo(w.x), bf_hi(w.x), bf_lo(w.y), bf_hi(w.y)}; ss += (yv[j][0] * yv[j][0] + yv[j][1] * yv[j][1]) + (yv[j][2] * yv[j][2] + yv[j][3] * yv[j][3]); } \
                const float rstd = rsqrtf(wave_sum(ss) * (1.0f / D) + EPS); \
                _Pragma("unroll") for (int j = 0; j < 4; ++j) V_[j] += A1[j] * yv[j] * rstd; \
                if (out_f32) { f32x4* xo = (f32x4*)(xout + (size_t)(ROW_) * D * 4) + lane; _Pragma("unroll") for (int j = 0; j < 4; ++j) xo[64 * j] = V_[j]; } \
                else { u32x2* xo = (u32x2*)(xout + (size_t)(ROW_) * D * 2) + lane; _Pragma("unroll") for (int j = 0; j < 4; ++j) { u32x2 w; w.x = pk_h2(V_[j][0], V_[j][1]); w.y = pk_h2(V_[j][2], V_[j][3]); xo[64 * j] = w; } } \
            } \
            if (hh) { \
                float ss = 0.f; \
                _Pragma("unroll") for (int j = 0; j < 4; ++j) ss += (V_[j][0] * V_[j][0] + V_[j][1] * V_[j][1]) + (V_[j][2] * V_[j][2] + V_[j][3] * V_[j][3]); \
                const float rstd = rsqrtf(wave_sum(ss) * (1.0f / D) + EPS); \
                u32x2* ho = (u32x2*)(h + (size_t)(ROW_) * D) + lane; \
                _Pragma("unroll") for (int j = 0; j < 4; ++j) { const f32x4 o = V_[j] * rstd * A2[j] + A3[j]; u32x2 w; w.x = cvt_pk_bf16(o[0], o[1]); w.y = cvt_pk_bf16(o[2], o[3]); ho[64 * j] = w; } \
            } } while (0)
#pragma unroll
        for (int j = 0; j < 4; ++j) { v0[j] = (f32x4){0.f, 0.f, 0.f, 0.f}; v1[j] = v0[j]; v2[j] = v0[j]; v3[j] = v0[j]; xb0[j] = (u32x2){0u, 0u}; xb1[j] = xb0[j]; xb2[j] = xb0[j]; xb3[j] = xb0[j]; yb0[j] = xb0[j]; yb1[j] = xb0[j]; yb2[j] = xb0[j]; yb3[j] = xb0[j]; }
        const int rbeg = aff ? 4096 * ax + 128 * aj + 16 * wave : b * SEQ + gw, rend = aff ? rbeg + 16 : (b + 1) * SEQ, rstep = aff ? 1 : NGW;
        if (rbeg < rend) NP_LOAD(rbeg, v0, xb0, yb0);
        if (rbeg + rstep < rend) NP_LOAD(rbeg + rstep, v1, xb1, yb1);
        if (rbeg + 2 * rstep < rend) NP_LOAD(rbeg + 2 * rstep, v2, xb2, yb2);
        for (int row = rbeg; row < rend; row += 4 * rstep) {
            if (row + 3 * rstep < rend) NP_LOAD(row + 3 * rstep, v3, xb3, yb3);
            NP_PROC(row, v0, xb0, yb0);
            if (row + 4 * rstep < rend) NP_LOAD(row + 4 * rstep, v0, xb0, yb0);
            if (row + rstep < rend) NP_PROC(row + rstep, v1, xb1, yb1);
            if (row + 5 * rstep < rend) NP_LOAD(row + 5 * rstep, v1, xb1, yb1);
            if (row + 2 * rstep < rend) NP_PROC(row + 2 * rstep, v2, xb2, yb2);
            if (row + 6 * rstep < rend) NP_LOAD(row + 6 * rstep, v2, xb2, yb2);
            if (row + 3 * rstep < rend) NP_PROC(row + 3 * rstep, v3, xb3, yb3);
        }
#undef NP_PROC
#undef NP_LOAD
    }
}

#define MFMA16(a, b, c) __builtin_amdgcn_mfma_f32_16x16x32_bf16((a), (b), (c), 0, 0, 0)
__device__ __forceinline__ void hgrn_phase(LAS unsigned char* lds, const bool full, const int dmode = 0) {
    const bool dummy = dmode != 0;
    const CAS Params* kpar = KP(); unsigned char* ws = kpar->ws; const float* onorm = kpar->in[10];
    constexpr int QM = 0, KM = 17408, QI = 34816, STO = 52224, PP = 87040, VTO = 96256, KDT = 114688, SEG = 133120, BL = 137216, RED = 137728;
    const int tid = TID(), lane = tid & 63, wave = __builtin_amdgcn_readfirstlane(tid >> 6), fr = lane & 15, fq = lane >> 4;
    const int kp = tid & 63, sg = tid >> 6;
    const bf16_t* qs = (const bf16_t*)(ws + OFF_R1); const bf16_t* kkp = (const bf16_t*)(ws + OFF_R1 + 64 * MiB); const bf16_t* ivp = (const bf16_t*)(ws + OFF_R1 + 128 * MiB);
    const bf16_t* lfp = (const bf16_t*)(ws + OFF_R2);   const bf16_t* gsp = (const bf16_t*)(ws + OFF_R2 + 128 * MiB);
    bf16_t* og = (bf16_t*)(ws + OFF_R1);
    f32x4* Lbuf = (f32x4*)(ws + OFF_YH); float* logDbuf = (float*)(ws + OFF_YH + 16 * MiB);
    LAS float* segs = (LAS float*)(lds + SEG); LAS float* blv = (LAS float*)(lds + BL); LAS float* red = (LAS float*)(lds + RED);
    const int vcu_ = __builtin_amdgcn_readfirstlane((int)*(volatile LAS unsigned*)(lds + LDS_BYTES - 8));
    const int item0 = gridDim.x == 256 ? (((vcu_ & 7) >> 2) * 8 + (vcu_ >> 5)) * 16 + 4 * (vcu_ & 3) + ((vcu_ >> 3) & 3) : BID();
    for (int item = item0; item < 256; item += gridDim.x) {
        const int bh = item >> 4, sc = item & 15, b = bh >> 3, hd = bh & 7;
        const size_t tok0 = (size_t)b * SEQ + (size_t)sc * 1024;
        f32x4 S[8];
#pragma unroll
        for (int vt = 0; vt < 8; ++vt) S[vt] = (f32x4){0.f, 0.f, 0.f, 0.f};
        f32x2v logD2 = (f32x2v){0.f, 0.f};
        __syncthreads();
        if (full) {
            f32x4 suff = (f32x4){0.f, 0.f, 0.f, 0.f};
            f32x4 La[8], Lb[8], lda, ldb;
#define HG_LLOAD(I_, L_, LD_) do { const int pit_ = bh * 16 + (I_); LD_ = *(const f32x4*)(logDbuf + pit_ * 128 + 16 * wave + fq * 4); \
                _Pragma("unroll") for (int vt = 0; vt < 8; ++vt) L_[vt] = Lbuf[(size_t)(pit_ * 8 + vt) * 512 + tid]; } while (0)
#pragma unroll
            for (int vt = 0; vt < 8; ++vt) { La[vt] = (f32x4){0.f, 0.f, 0.f, 0.f}; Lb[vt] = La[vt]; }
            lda = La[0]; ldb = La[0];
            if (sc > 0) HG_LLOAD(sc - 1, La, lda);
            for (int i = sc - 1; i >= 0; --i) {
                if (i > 0) HG_LLOAD(i - 1, Lb, ldb);
                asm volatile("" : "+v"(La[0]), "+v"(La[1]), "+v"(La[2]), "+v"(La[3]), "+v"(La[4]), "+v"(La[5]), "+v"(La[6]), "+v"(La[7]), "+v"(lda));
                const f32x4 pk = (f32x4){fexp(suff[0]), fexp(suff[1]), fexp(suff[2]), fexp(suff[3])};
#pragma unroll
                for (int vt = 0; vt < 8; ++vt) { S[vt] += La[vt] * pk; La[vt] = Lb[vt]; }
                suff += lda; lda = ldb; }
#undef HG_LLOAD
#pragma unroll
            for (int vt = 0; vt < 8; ++vt) { u32x2 w; w.x = cvt_pk_bf16(S[vt][0], S[vt][1]); w.y = cvt_pk_bf16(S[vt][2], S[vt][3]);
                *(LAS u32x2*)(lds + STO + (16 * vt + fr) * 272 + (16 * wave + fq * 4) * 2) = w; }
        }
        f32x2v lf2[8]; unsigned v2[8], q2[8];
#define HG_LOAD(CI) do { const size_t gb_ = (tok0 + (size_t)(CI) * 64 + sg * 8) * 1024 + hd * 128 + 2 * kp; \
            _Pragma("unroll") for (int i = 0; i < 8; ++i) { { const unsigned lw_ = *(const unsigned*)(lfp + gb_ + (size_t)i * 1024); lf2[i] = (f32x2v){h_lo(lw_), h_hi(lw_)}; } v2[i] = *(const unsigned*)(ivp + gb_ + (size_t)i * 1024); \
                q2[i] = full ? *(const unsigned*)(qs + gb_ + (size_t)i * 1024) : 0u; } } while (0)
        f32x4 onv[4];
#pragma unroll
        for (int j = 0; j < 4; ++j) onv[j] = *(const f32x4*)(onorm + 16 * ((wave >> 2) * 4 + j) + fq * 4);
        HG_LOAD(0);
        for (int ci = 0; ci < 16; ++ci) {
            const size_t t0 = tok0 + (size_t)ci * 64;
            f32x2v run = (f32x2v){0.f, 0.f}, kraw[8];
#pragma unroll
            for (int i = 0; i < 8; ++i) { kraw[i] = (f32x2v){1.f - fexp(lf2[i].x), 1.f - fexp(lf2[i].y)}; run += lf2[i]; lf2[i] = run; }
            *(LAS f32x2v*)(segs + sg * 128 + 2 * kp) = run;
            LDS_BARRIER();
            f32x2v prefix = (f32x2v){0.f, 0.f}, bmid = prefix, blast = prefix;
#pragma unroll
            for (int s_ = 0; s_ < 8; ++s_) { const f32x2v sv = *(const LAS f32x2v*)(segs + s_ * 128 + 2 * kp); if (s_ < sg) prefix += sv; if (s_ < 4) bmid += sv; blast += sv; }
            if (sg == 0) { *(LAS f32x2v*)(blv + 2 * kp) = blast; logD2 += blast; }
            if (dmode != 3) {
                unsigned kda[4], kdb[4], vta[4], vtb[4];
#pragma unroll
                for (int i = 0; i < 8; i += 2) {
                    const f32x2v bb0 = prefix + lf2[i], bb1 = prefix + lf2[i + 1];
                    const float ka0 = kraw[i].x, kb0 = kraw[i].y, ka1 = kraw[i + 1].x, kb1 = kraw[i + 1].y;
                    kda[i >> 1] = cvt_pk_bf16(ka0 * fexp(blast.x - bb0.x), ka1 * fexp(blast.x - bb1.x));
                    kdb[i >> 1] = cvt_pk_bf16(kb0 * fexp(blast.y - bb0.y), kb1 * fexp(blast.y - bb1.y));
                    vta[i >> 1] = (v2[i] & 0xffffu) | (v2[i + 1] << 16);
                    vtb[i >> 1] = (v2[i] >> 16) | (v2[i + 1] & 0xffff0000u);
                    if (full) {
                        const int ta = sg * 8 + i;
                        { const float qa = bf_lo(q2[i]), qb = bf_hi(q2[i]);
                          *(LAS unsigned*)(lds + QM + ta * 272 + kp * 4) = cvt_pk_bf16(qa * fexp(bb0.x - bmid.x), qb * fexp(bb0.y - bmid.y));
                          *(LAS unsigned*)(lds + KM + ta * 272 + kp * 4) = cvt_pk_bf16(ka0 * fexp(bmid.x - bb0.x), kb0 * fexp(bmid.y - bb0.y));
                          *(LAS unsigned*)(lds + QI + ta * 272 + kp * 4) = cvt_pk_bf16(qa * fexp(bb0.x), qb * fexp(bb0.y)); }
                        { const float qa = bf_lo(q2[i + 1]), qb = bf_hi(q2[i + 1]);
                          *(LAS unsigned*)(lds + QM + (ta + 1) * 272 + kp * 4) = cvt_pk_bf16(qa * fexp(bb1.x - bmid.x), qb * fexp(bb1.y - bmid.y));
                          *(LAS unsigned*)(lds + KM + (ta + 1) * 272 + kp * 4) = cvt_pk_bf16(ka1 * fexp(bmid.x - bb1.x), kb1 * fexp(bmid.y - bb1.y));
                          *(LAS unsigned*)(lds + QI + (ta + 1) * 272 + kp * 4) = cvt_pk_bf16(qa * fexp(bb1.x), qb * fexp(bb1.y)); }
                    }
                }
                *(LAS u32x4*)(lds + KDT + (2 * kp) * 144 + sg * 16) = (u32x4){kda[0], kda[1], kda[2], kda[3]}; *(LAS u32x4*)(lds + KDT + (2 * kp + 1) * 144 + sg * 16) = (u32x4){kdb[0], kdb[1], kdb[2], kdb[3]};
                *(LAS u32x4*)(lds + VTO + (2 * kp) * 144 + sg * 16) = (u32x4){vta[0], vta[1], vta[2], vta[3]}; *(LAS u32x4*)(lds + VTO + (2 * kp + 1) * 144 + sg * 16) = (u32x4){vtb[0], vtb[1], vtb[2], vtb[3]};
            }
            LDS_BARRIER();
            if (ci + 1 < 16) HG_LOAD(ci + 1);
            if (dmode == 2) continue;
            f32x4 O[4];
            const int tt = wave & 3, vh = wave >> 2;
            const size_t orow = (t0 + 16 * tt + fr) * 1024 + hd * 128;
            u32x2 g2[4];
#pragma unroll
            for (int j = 0; j < 4; ++j) g2[j] = full ? *(const u32x2*)(gsp + orow + 16 * (vh * 4 + j) + fq * 4) : (u32x2){0u, 0u};
#define FRAG(BASE_, ROW_, STRIDE_, KS_) (*(const LAS bf16x8*)(lds + (BASE_) + (ROW_) * (STRIDE_) + ((KS_) * 32 + fq * 8) * 2))
#define PIN5(a_, b_, c_, d_, e_) asm volatile("" : "+v"(a_), "+v"(b_), "+v"(c_), "+v"(d_), "+v"(e_))
#define PIN4(a_, b_, c_, d_) asm volatile("" : "+v"(a_), "+v"(b_), "+v"(c_), "+v"(d_))
            if (full) {
                { const int ta = wave >> 1, st0 = (wave & 1) * 2;
                  bf16x8 yq[4], xk0[4], xk1[4];
#pragma unroll
                  for (int ks = 0; ks < 4; ++ks) { yq[ks] = FRAG(QM, 16 * ta + fr, 272, ks); xk0[ks] = FRAG(KM, 16 * st0 + fr, 272, ks); xk1[ks] = FRAG(KM, 16 * (st0 + 1) + fr, 272, ks); }
                  PIN4(yq[0], yq[1], yq[2], yq[3]); PIN4(xk0[0], xk0[1], xk0[2], xk0[3]); PIN4(xk1[0], xk1[1], xk1[2], xk1[3]);
#pragma unroll
                  for (int e = 0; e < 2; ++e) { const int st = st0 + e;
                    f32x4 a = (f32x4){0.f, 0.f, 0.f, 0.f};
                    if (st <= ta) {
#pragma unroll
                        for (int ks = 0; ks < 4; ++ks) a = MFMA16(e ? xk1[ks] : xk0[ks], yq[ks], a);
                        const int tg = 16 * ta + fr, sgl = 16 * st + fq * 4;
#pragma unroll
                        for (int r = 0; r < 4; ++r) a[r] = (sgl + r <= tg) ? a[r] : 0.f;
                    }
                    u32x2 w; w.x = cvt_pk_bf16(a[0], a[1]); w.y = cvt_pk_bf16(a[2], a[3]);
                    *(LAS u32x2*)(lds + PP + (16 * ta + fr) * 144 + (16 * st + fq * 4) * 2) = w; } }
#pragma unroll
                for (int j = 0; j < 4; ++j) O[j] = (f32x4){0.f, 0.f, 0.f, 0.f};
                { bf16x8 fy[2], fx[2][4];
                  fy[0] = FRAG(QI, 16 * tt + fr, 272, 0);
#pragma unroll
                  for (int j = 0; j < 4; ++j) fx[0][j] = FRAG(STO, 16 * (vh * 4 + j) + fr, 272, 0);
#pragma unroll
                  for (int ks = 0; ks < 4; ++ks) { const int cb = ks & 1, nb = cb ^ 1;
                    if (ks < 3) { fy[nb] = FRAG(QI, 16 * tt + fr, 272, ks + 1);
#pragma unroll
                        for (int j = 0; j < 4; ++j) fx[nb][j] = FRAG(STO, 16 * (vh * 4 + j) + fr, 272, ks + 1); }
                    PIN5(fy[cb], fx[cb][0], fx[cb][1], fx[cb][2], fx[cb][3]);
#pragma unroll
                    for (int j = 0; j < 4; ++j) O[j] = MFMA16(fx[cb][j], fy[cb], O[j]); } }
                LDS_BARRIER();
            }
            { bf16x8 xkd[2], yp[2], yb[2][4];
#pragma unroll
              for (int ks = 0; ks < 2; ++ks) { xkd[ks] = FRAG(KDT, 16 * wave + fr, 144, ks); yp[ks] = full ? FRAG(PP, 16 * tt + fr, 144, ks) : xkd[ks]; }
#pragma unroll
              for (int j = 0; j < 4; ++j) yb[0][j] = FRAG(VTO, 16 * j + fr, 144, 0);
              const f32x4 bl4 = *(const LAS f32x4*)(lds + BL + (16 * wave + fq * 4) * 4);
              const f32x4 dk = (f32x4){fexp(bl4[0]), fexp(bl4[1]), fexp(bl4[2]), fexp(bl4[3])};
#pragma unroll
              for (int vt = 0; vt < 8; ++vt) S[vt] = S[vt] * dk;
              PIN4(xkd[0], xkd[1], yp[0], yp[1]);
#pragma unroll
              for (int bi = 0; bi < 4; ++bi) { const int ks = bi >> 1, hf = bi & 1, cb = bi & 1, nb = cb ^ 1;
                  if (bi < 3) {
#pragma unroll
                      for (int j = 0; j < 4; ++j) yb[nb][j] = FRAG(VTO, 16 * (((bi + 1) & 1) * 4 + j) + fr, 144, (bi + 1) >> 1); }
                  PIN4(yb[cb][0], yb[cb][1], yb[cb][2], yb[cb][3]);
                  if (full && hf == vh) {
#pragma unroll
                      for (int j = 0; j < 4; ++j) O[j] = MFMA16(yb[cb][j], yp[ks], O[j]); }
#pragma unroll
                  for (int j = 0; j < 4; ++j) S[hf * 4 + j] = MFMA16(xkd[ks], yb[cb][j], S[hf * 4 + j]); } }
#undef FRAG
#undef PIN5
#undef PIN4
            if (full) {
#pragma unroll
                for (int vt = 0; vt < 8; ++vt) { u32x2 w; w.x = cvt_pk_bf16(S[vt][0], S[vt][1]); w.y = cvt_pk_bf16(S[vt][2], S[vt][3]);
                    *(LAS u32x2*)(lds + STO + (16 * vt + fr) * 272 + (16 * wave + fq * 4) * 2) = w; }
                float ssq = 0.f;
#pragma unroll
                for (int j = 0; j < 4; ++j) ssq += (O[j][0] * O[j][0] + O[j][1] * O[j][1]) + (O[j][2] * O[j][2] + O[j][3] * O[j][3]);
                ssq += __shfl_xor(ssq, 16); ssq += __shfl_xor(ssq, 32);
                if (fq == 0) red[vh * 64 + 16 * tt + fr] = ssq;
                LDS_BARRIER();
                const float rstd = rsqrtf((red[16 * tt + fr] + red[64 + 16 * tt + fr]) * (1.0f / 128.0f) + EPS);
#pragma unroll
                for (int j = 0; j < 4; ++j) { const int v0 = 16 * (vh * 4 + j) + fq * 4;
                    const f32x4 o = O[j] * rstd * onv[j] * (f32x4){bf_lo(g2[j].x), bf_hi(g2[j].x), bf_lo(g2[j].y), bf_hi(g2[j].y)};
                    u32x2 w; w.x = cvt_pk_bf16(o[0], o[1]); w.y = cvt_pk_bf16(o[2], o[3]);
                    if (!dummy) *(u32x2*)(og + orow + v0) = w; }
            }
        }
        if (!full) {
#pragma unroll
            for (int vt = 0; vt < 8; ++vt) Lbuf[(size_t)(item * 8 + vt) * 512 + tid] = S[vt];
            if (sg == 0) *(f32x2v*)(logDbuf + item * 128 + 2 * kp) = logD2;
        }
    }
}

__device__ __forceinline__ void spatial_phase(LAS unsigned char* lds, const int dmode = 0) {
    const bool dummy = dmode != 0;
    const CAS Params* kp = KP(); unsigned char* ws = kp->ws; const float* lng = kp->in[14]; const float* lnb = kp->in[15]; const float* wsp = kp->in[16]; const float* bsp = kp->in[17];
    constexpr int WM = 0, VN0 = 34816, VNH = 52224, MU = 139264;
    const int tid = TID(), lane = tid & 63, wave = __builtin_amdgcn_readfirstlane(tid >> 6), fr = lane & 15, fq = lane >> 4;
    bf16_t* u = (bf16_t*)(ws + OFF_R1); const bf16_t* vT = (const bf16_t*)(ws + OFF_R2); const f32x2v* part = (const f32x2v*)(ws + OFF_PART);
    const int c = BID(), G = (int)gridDim.x;
    const int vcu_ = __builtin_amdgcn_readfirstlane((int)*(volatile LAS unsigned*)(lds + LDS_BYTES - 8));
    const bool aff = G == 256;
    const int g = aff ? ((vcu_ >> 3) & 7) : (c & 7), n0 = aff ? 32 * (vcu_ & 7) + (vcu_ >> 6) : (c >> 3), nstep = aff ? 4 : ((G + 7 - g) >> 3);
    int nitems = aff ? 8 : (n0 < 256 ? (256 - n0 + nstep - 1) / nstep : 0);
    if (nitems > 8) nitems = 8;
    if (nitems == 0) return;
    __syncthreads();
    for (int e = tid; e < nitems * 128; e += 512) { const int it = e >> 7, tk = e & 127; const size_t tok = (size_t)(n0 + it * nstep) * 128 + tk;
        float s_ = 0.f, q_ = 0.f;
#pragma unroll
        for (int pi = 0; pi < 24; ++pi) { const f32x2v v_ = part[(size_t)pi * T + tok]; s_ += v_.x; q_ += v_.y; }
        const float m_ = s_ * (1.0f / 3072.0f), var_ = q_ * (1.0f / 3072.0f) - m_ * m_;
        LAS float* mu_ = (LAS float*)(lds + MU + it * 1024); mu_[tk] = m_; mu_[128 + tk] = rsqrtf(var_ + EPS); }
    f32x4 wst[8];
#pragma unroll
    for (int i = 0; i < 8; ++i) { const int idx = tid + 512 * i, t = idx >> 5, s4 = (idx & 31) * 4; wst[i] = *(const f32x4*)(wsp + (size_t)(g * 128 + t) * 128 + s4); }
    asm volatile("" : "+v"(wst[0]), "+v"(wst[1]), "+v"(wst[2]), "+v"(wst[3]), "+v"(wst[4]), "+v"(wst[5]), "+v"(wst[6]), "+v"(wst[7]));
#pragma unroll
    for (int i = 0; i < 8; ++i) { const int idx = tid + 512 * i, t = idx >> 5, s4 = (idx & 31) * 4;
        const f32x4 w = wst[i];
        u32x2 o; o.x = cvt_pk_bf16(s4 + 0 <= t ? w[0] : 0.f, s4 + 1 <= t ? w[1] : 0.f); o.y = cvt_pk_bf16(s4 + 2 <= t ? w[2] : 0.f, s4 + 3 <= t ? w[3] : 0.f);
        *(LAS u32x2*)(lds + WM + t * 272 + s4 * 2) = o; }
    u32x4 rawA[6], rawB[6]; float lgA[6], lgB[6], lbA[6], lbB[6];
#define SP_LOAD(HI_, RAW_, LG_, LB_) do { const int n_ = n0 + ((HI_) >> 1) * nstep, h_ = (HI_) & 1; _Pragma("unroll") for (int i = 0; i < 6; ++i) { const int piece = tid + 512 * i, cl = piece >> 4, s8 = (piece & 15) * 8; const int ch = g * 384 + h_ * 192 + cl; \
        RAW_[i] = *(const u32x4*)(vT + ((size_t)n_ * 3072 + ch) * 128 + s8); LG_[i] = lng[ch]; LB_[i] = lnb[ch]; } } while (0)
    const int nst = 2 * nitems;
    SP_LOAD(0, rawA, lgA, lbA);
    SP_LOAD(1, rawB, lgB, lbB);
    const float bs = bsp[g * 128 + 16 * wave + fr];
    const int nks = (wave >> 1) + 1;
    __syncthreads();
#define SP_STAGE(HI_, RAW_, LG_, LB_) do { \
        const int it_ = (HI_) >> 1, half_ = (HI_) & 1, n_ = n0 + it_ * nstep; \
        if (dmode != 3) { const LAS float* mu = (const LAS float*)(lds + MU + it_ * 1024); const int s8 = (tid & 15) * 8;     \
          const f32x4 m0 = *(const LAS f32x4*)(mu + s8), m1 = *(const LAS f32x4*)(mu + s8 + 4), r0 = *(const LAS f32x4*)(mu + 128 + s8), r1 = *(const LAS f32x4*)(mu + 128 + s8 + 4); \
          _Pragma("unroll") for (int i = 0; i < 6; ++i) { const int piece = tid + 512 * i, cl = piece >> 4; \
            const int j = cl & 31, lrow = (cl & ~31) + ((j >> 2) & 1) * 16 + (j >> 3) * 4 + (j & 3); \
            f32x4 a = (f32x4){bf_lo(RAW_[i].x), bf_hi(RAW_[i].x), bf_lo(RAW_[i].y), bf_hi(RAW_[i].y)}, bq = (f32x4){bf_lo(RAW_[i].z), bf_hi(RAW_[i].z), bf_lo(RAW_[i].w), bf_hi(RAW_[i].w)}; \
            a = (a - m0) * r0 * LG_[i] + LB_[i]; bq = (bq - m1) * r1 * LG_[i] + LB_[i]; \
            *(LAS u32x4*)(lds + VN0 + half_ * VNH + lrow * 272 + s8 * 2) = pack8(a, bq); } } \
        LDS_BARRIER(); \
        if ((HI_) + 2 < nst) SP_LOAD((HI_) + 2, RAW_, LG_, LB_); \
        bf16_t* ub = u + ((size_t)n_ * 128 + 16 * wave + fr) * 3072 + g * 384 + half_ * 192 + fq * 8; \
        bf16x8 yf[4]; \
        _Pragma("unroll") for (int ks = 0; ks < 4; ++ks) yf[ks] = *(const LAS bf16x8*)(lds + WM + (16 * wave + fr) * 272 + (ks * 32 + fq * 8) * 2); \
        if (dmode != 2) { \
          bf16x8 xa[2][4], xb[2][4]; \
          _Pragma("unroll") for (int ks = 0; ks < 4; ++ks) { xa[0][ks] = yf[ks]; xb[0][ks] = yf[ks]; xa[1][ks] = yf[ks]; xb[1][ks] = yf[ks]; } \
          _Pragma("unroll") for (int ks = 0; ks < 4; ++ks) if (ks < nks) { xa[0][ks] = *(const LAS bf16x8*)(lds + VN0 + half_ * VNH + fr * 272 + (ks * 32 + fq * 8) * 2); xb[0][ks] = *(const LAS bf16x8*)(lds + VN0 + half_ * VNH + (16 + fr) * 272 + (ks * 32 + fq * 8) * 2); } \
          _Pragma("unroll") for (int p2 = 0; p2 < 6; ++p2) { const int cb = p2 & 1, nb = cb ^ 1; \
            if (p2 < 5) { _Pragma("unroll") for (int ks = 0; ks < 4; ++ks) if (ks < nks) { \
                xa[nb][ks] = *(const LAS bf16x8*)(lds + VN0 + half_ * VNH + (32 * (p2 + 1) + fr) * 272 + (ks * 32 + fq * 8) * 2); \
                xb[nb][ks] = *(const LAS bf16x8*)(lds + VN0 + half_ * VNH + (32 * (p2 + 1) + 16 + fr) * 272 + (ks * 32 + fq * 8) * 2); } } \
            asm volatile("" : "+v"(xa[cb][0]), "+v"(xa[cb][1]), "+v"(xa[cb][2]), "+v"(xa[cb][3])); asm volatile("" : "+v"(xb[cb][0]), "+v"(xb[cb][1]), "+v"(xb[cb][2]), "+v"(xb[cb][3])); \
            f32x4 a0 = (f32x4){0.f, 0.f, 0.f, 0.f}, a1 = a0; \
            _Pragma("unroll") for (int ks = 0; ks < 4; ++ks) if (ks < nks) { a0 = MFMA16(xa[cb][ks], yf[ks], a0); a1 = MFMA16(xb[cb][ks], yf[ks], a1); } \
            if (!dummy) *(u32x4*)(ub + 32 * p2) = pack8(a0 + bs, a1 + bs); } } \
    } while (0)
    for (int hi = 0; hi < nst; hi += 2) {
        SP_STAGE(hi, rawA, lgA, lbA);
        SP_STAGE(hi + 1, rawB, lgB, lbB);
    }
#undef SP_STAGE
#undef SP_LOAD
}

#ifndef GEMM_ALIGN
#define GEMM_ALIGN true
#endif
#ifndef GEMM_SP2
#define GEMM_SP2 true
#endif
enum { PT_PREP0 = 0, PT_NORM, PT_G1, PT_G2, PT_GPROJ, PT_H1, PT_H2, PT_GHOUT, PT_GV, PT_SPATIAL, PT_GU, PT_GMOUT };
constexpr int N_PHASES = 24;
__global__ void __launch_bounds__(512, 2) mega(Params p_unused) {
    extern __shared__ __attribute__((aligned(16))) unsigned char smem[];
    LAS unsigned char* lds = (LAS unsigned char*)smem;
    cg::grid_group grid = cg::this_grid();
    const int ph_lo = KP()->ph_lo, ph_hi = KP()->ph_hi;
    volatile LAS unsigned* xst = (volatile LAS unsigned*)(lds + LDS_BYTES - 16);
    if (threadIdx.x == 0) { xst[0] = 0u; xst[1] = 0u; xst[2] = blockIdx.x; xst[3] = 0u; }
    __syncthreads();
    XcdBarrier xb; xb.bar = (unsigned*)(KP()->ws + OFF_BAR); xb.x = xb_xcc_id(); xb.st = xst;
    if (ph_hi - ph_lo > 1) {
        xb = xcd_barrier_post((unsigned*)(KP()->ws + OFF_BAR), xst);
        if (threadIdx.x == 0) xst[3] = xb_add(&xb.bar[4 * xb.x], 1u);
    }
    for (int ph = ph_lo; ph < ph_hi; ++ph) {
        int type, a0 = 0, a1 = 0, a2 = -1, a3 = 0, a4 = 0;
        switch (ph) {
            case 0: type = PT_PREP0; break;
            case 1: type = PT_NORM; a0 = -1; a2 = 0; a3 = 0; break;
            case 2: type = PT_G1; a0 = 0; a1 = 0; break;
            case 3: type = PT_G2; a0 = 0; a1 = 0; break;
            case 4: type = PT_NORM; a0 = 0; a1 = 0; a2 = 0; a3 = 1; break;
            case 5: type = PT_GPROJ; break;
            case 6: type = PT_H1; break;
            case 7: type = PT_H2; break;
            case 8: type = PT_GHOUT; break;
            case 9: type = PT_NORM; a0 = 0; a1 = 1; a2 = 0; a3 = 2; break;
            case 10: type = PT_G1; a0 = 0; a1 = 1; break;
            case 11: type = PT_G2; a0 = 0; a1 = 1; break;
            case 12: type = PT_NORM; a0 = 0; a1 = 2; a2 = 1; a3 = 0; a4 = 1; break;
            case 13: type = PT_G1; a0 = 1; a1 = 0; break;
            case 14: type = PT_G2; a0 = 1; a1 = 0; break;
            case 15: type = PT_NORM; a0 = 1; a1 = 0; a2 = 1; a3 = 1; break;
            case 16: type = PT_GV; break;
            case 17: type = PT_SPATIAL; break;
            case 18: type = PT_GU; break;
            case 19: type = PT_GMOUT; break;
            case 20: type = PT_NORM; a0 = 1; a1 = 1; a2 = 1; a3 = 2; break;
            case 21: type = PT_G1; a0 = 1; a1 = 1; break;
            case 22: type = PT_G2; a0 = 1; a1 = 1; break;
            default: type = PT_NORM; a0 = 1; a1 = 2; a2 = -1; break;
        }
#ifndef EN
#define EN 0xff
#endif
#ifndef PROBE
#define PROBE 0
#endif
        for (int rep = 0; rep < (PROBE == 4 ? 2 : 1); ++rep) {
        if ((EN & 1) && (type == PT_PREP0 || (type == PT_NORM && a4))) prep_weights(lds, type == PT_PREP0 ? 0 : 1);
        if ((EN & 2) && type == PT_PREP0) mod_gemv(lds);
        }
        const int xsrc = ph <= 4 ? 0 : (ph == N_PHASES - 1 ? 2 : 1), xdst = ph == N_PHASES - 1 ? 3 : (ph == 20 ? 2 : 1);
        if (PROBE == 3 && type == PT_NORM) norm_phase(a0, a1, a2, a3, xsrc, xdst, true, __builtin_amdgcn_readfirstlane((int)xst[2]));
        if ((EN & 4) && type == PT_NORM) norm_phase(a0, a1, a2, a3, xsrc, xdst, false, __builtin_amdgcn_readfirstlane((int)xst[2]));
        for (int rep = 0; rep < (((PROBE == 2 && type == PT_H1) || ((PROBE == 5 || PROBE == 13 || PROBE == 14) && type == PT_H2)) ? 2 : 1); ++rep)
        if ((EN & 8) && (type == PT_H1 || type == PT_H2)) hgrn_phase(lds, type == PT_H2, (rep == 0 && type == PT_H2) ? (PROBE == 5 ? 1 : PROBE == 13 ? 2 : PROBE == 14 ? 3 : 0) : 0);
        for (int rep = 0; rep < ((PROBE == 6 || PROBE == 11 || PROBE == 12) ? 2 : 1); ++rep)
        if ((EN & 16) && type == PT_SPATIAL) spatial_phase(lds, rep == 0 ? (PROBE == 6 ? 1 : PROBE == 11 ? 2 : PROBE == 12 ? 3 : 0) : 0);
        if ((EN & 32) && (type == PT_G1 || type == PT_G2 || type == PT_GPROJ || type == PT_GHOUT || type == PT_GV || type == PT_GU || type == PT_GMOUT)) {
            const int ncall = 1;
            for (int cj = 0; cj < ncall * (((PROBE == 1 && type != PT_GU) || PROBE == 8 || PROBE == 10) ? 2 : 1); ++cj) { const int ci = cj % ncall;
                unsigned char* ws = KP()->ws;
                const bf16_t* Wb = (const bf16_t*)(ws + OFF_W);
                pg8::Gemm g; Epi E; E.mode_in = 0;
                g.A = (const bf16_t*)(ws + OFF_YH); g.M = T; g.N = D; g.K = D; g.Bt = Wb;
                if (type == PT_G1) { g.Bt = Wb + (a1 ? W_IN1 : W_IN0); g.N = 2 * DFF; g.K = D; E.mode_in = 1; }
                else if (type == PT_G2) { g.A = (const bf16_t*)(ws + OFF_R1); g.Bt = Wb + (a1 ? W_OUT1 : W_OUT0); g.N = D; g.K = DFF; }
                else if (type == PT_GPROJ) { g.Bt = Wb + W_X; g.N = 4096; g.K = D; E.mode_in = 2; }
                else if (type == PT_GHOUT) { g.A = (const bf16_t*)(ws + OFF_R1); g.Bt = Wb + W_HGOUT; g.N = D; g.K = D; }
                else if (type == PT_GMOUT) { g.A = (const bf16_t*)(ws + OFF_R1); g.Bt = Wb + W_GMOUT; g.N = D; g.K = 3072; }
                else if (type == PT_GU) { g.Bt = Wb + W_X; g.N = 3072; g.K = D; E.mode_in = 3; }
                else { g.A = Wb + W_X + (size_t)3072 * D; g.M = 3072; g.Bt = (const bf16_t*)(ws + OFF_YH); g.N = T; g.K = D; E.mode_in = 4; }
                if (PROBE == 8 && cj < ncall) E.mode_in = 7;
                if (PROBE == 10 && cj < ncall) E.mode_in |= 8;
                const int vcu = __builtin_amdgcn_readfirstlane((int)xst[2]);
                pg8::StaticOrder S; S.init(g.M, g.N, (int)gridDim.x, vcu);
                __syncthreads();
                pg8::gemm_phase<Epi, pg8::StaticOrder, GEMM_ALIGN, GEMM_SP2>(lds, g, S, E);
                __syncthreads();
            }
        }
        if (ph + 1 < ph_hi) {
            if (ph_hi > N_PHASES) grid.sync();
            xb.bar = (unsigned*)(KP()->ws + OFF_BAR); xcd_barrier(xb);
            if (PROBE == 7) { xcd_barrier(xb); xcd_barrier(xb); xcd_barrier(xb); }
            if (ph == ph_lo) {
                if (threadIdx.x == 0) { bool even = (gridDim.x & 7u) == 0u;
                    for (unsigned j = 0; j < 16; ++j) { const unsigned cnt = xb_ld(&xb.bar[XB_XCNT(j)]); even = even && (cnt == (j < 8 ? gridDim.x / 8u : 0u)); }
                    if (even && xb.x < 8u) xst[2] = xb.x + 8u * xst[3]; }
                __syncthreads();
            }
        }
    }
}

#ifndef MK_MULTI
#define MK_MULTI 0
#endif
extern "C" void kernel_launch(void* const* d_in, const int* in_sizes, int n_in, void* d_out, int out_size, void* d_ws, size_t ws_size, hipStream_t stream) {
    static int grid = 0;
    if (grid == 0) {
        if (n_in != 19 || in_sizes[0] != T * D || out_size != T * D || ws_size < WS_END) { fprintf(stderr, "kernel_launch: unexpected shapes / workspace: n_in %d in0 %d out %d ws %zu (need %zu)\n", n_in, n_in > 0 ? in_sizes[0] : -1, out_size, ws_size, (size_t)WS_END); grid = -1; return; }
        int dev = 0, cus = 0, per_cu = 0;
        if (hipGetDevice(&dev) != hipSuccess || hipDeviceGetAttribute(&cus, hipDeviceAttributeMultiprocessorCount, dev) != hipSuccess) { fprintf(stderr, "kernel_launch: device query failed\n"); grid = -1; return; }
        if (hipFuncSetAttribute((const void*)mega, hipFuncAttributeMaxDynamicSharedMemorySize, LDS_BYTES) != hipSuccess) { fprintf(stderr, "kernel_launch: hipFuncSetAttribute failed\n"); grid = -1; return; }
        if (hipOccupancyMaxActiveBlocksPerMultiprocessor(&per_cu, (const void*)mega, 512, LDS_BYTES) != hipSuccess || per_cu < 1) { fprintf(stderr, "kernel_launch: occupancy query says %d blocks per CU\n", per_cu); per_cu = 1; }
        (void)hipGetLastError();
        grid = cus;
    }
    if (grid < 0) return;
    if (hipMemsetAsync((unsigned char*)d_ws + OFF_BAR, 0, 16384, stream) != hipSuccess) { fprintf(stderr, "kernel_launch: hipMemsetAsync failed\n"); return; }
    Params p{};
    for (int i = 0; i < 19; ++i) p.in[i] = (const float*)d_in[i];
    p.out = (float*)d_out; p.ws = (unsigned char*)d_ws;
#if MK_MULTI
    for (int ph = 0; ph < N_PHASES; ++ph) { p.ph_lo = ph; p.ph_hi = ph + 1; hipLaunchKernelGGL(mega, dim3(grid), dim3(512), LDS_BYTES, stream, p); }
#else
    p.ph_lo = 0; p.ph_hi = N_PHASES;
    void* args[] = {&p};
    hipError_t e = hipLaunchCooperativeKernel((const void*)mega, dim3(grid), dim3(512), args, LDS_BYTES, stream);
    if (e != hipSuccess) fprintf(stderr, "kernel_launch: cooperative launch failed: %s (grid %d)\n", hipGetErrorString(e), grid);
#endif
}
```
